# Optimizing an MI355X kernel written in HIP

```python
import math
import jax, jax.numpy as jnp
from jax import lax
import numpy as np

D_MODEL = 1024
BATCH = 8
SEQ = 2048
DEPTH = 1
DEC_BATCH = 128
DEC_SEQ = 8
PAST_LEN = 16384
PAGE_SIZE = 128

D_MIX = D_MODEL
D_GLA = D_MIX // 2
GLA_HEADS = 4
GLA_DV = D_GLA // GLA_HEADS
GLA_DK = GLA_DV // 2
GLA_KDIM = GLA_HEADS * GLA_DK
GLA_GATE_RANK = 16
GLA_GATE_NORM = 16.0
GLA_CHUNK = 64
D_S5 = D_MIX - D_GLA
S5_GROUP = 16
S5_GROUPS = D_S5 // S5_GROUP
S5_STATE = 64
N_META = 16
D_FF = ((-(-(8 * D_MODEL) // 3) + 255) // 256) * 256
D_IN = 2 * GLA_KDIM + 2 * D_GLA + GLA_GATE_RANK + D_S5
EPS = 1e-6

kernel_name = "hymba_gla_s5_sandwich_step"


def rms_norm(x, g):
    xf = x.astype(jnp.float32)
    y = xf * lax.rsqrt(jnp.mean(xf * xf, axis=-1, keepdims=True) + EPS)
    return (y * g.astype(jnp.float32)).astype(x.dtype)


def gla_chunked(q, k, v, lg, s0, chunk):
    bsz, length, nh, dk = q.shape
    dv = v.shape[-1]
    nc = length // chunk

    def to_chunks(t):
        return t.reshape(bsz, nc, chunk, nh, t.shape[-1]).transpose(1, 0, 3, 2, 4)

    qc, kc, vc, gc = to_chunks(q), to_chunks(k), to_chunks(v), to_chunks(lg)
    b = jnp.cumsum(gc, axis=3)
    b_last = b[:, :, :, -1:, :]
    q_dec = qc * jnp.exp(b)
    k_inv = kc * jnp.exp(-b)
    k_end = kc * jnp.exp(b_last - b)
    causal = jnp.tril(jnp.ones((chunk, chunk), dtype=bool))

    def step(S, xs):
        q_i, k_i, ke_i, v_i, bl_i = xs
        att = jnp.where(causal, jnp.einsum('bhtd,bhsd->bhts', q_i, k_i), 0.0)
        o = jnp.einsum('bhts,bhsv->bhtv', att, v_i) + jnp.einsum('bhtd,bhdv->bhtv', q_i, S)
        S = jnp.exp(bl_i[..., 0, :])[..., None] * S + jnp.einsum('bhsd,bhsv->bhdv', ke_i, v_i)
        return S, o

    S, o = lax.scan(step, s0, (q_dec, k_inv, k_end, vc, b_last))
    o = o.transpose(1, 0, 3, 2, 4).reshape(bsz, length, nh, dv)
    return o, S


def s5_scan(u, h0_re, h0_im, a_re, a_im, b_re, b_im, c_re, c_im, d_skip, log_dt):
    f32 = jnp.float32
    bsz, length, _ = u.shape
    uf = u.astype(f32)
    ug = uf.reshape(bsz, length, S5_GROUPS, S5_GROUP)
    lam_re = jnp.minimum(a_re.astype(f32), -1e-4)
    lam_im = a_im.astype(f32)
    dt = jnp.exp(log_dt.astype(f32))[:, None]
    mag = jnp.exp(lam_re * dt)
    abar_re = mag * jnp.cos(lam_im * dt)
    abar_im = mag * jnp.sin(lam_im * dt)
    den = lam_re * lam_re + lam_im * lam_im
    nr, ni = abar_re - 1.0, abar_im
    f_re = (nr * lam_re + ni * lam_im) / den
    f_im = (ni * lam_re - nr * lam_im) / den
    br, bi = b_re.astype(f32), b_im.astype(f32)
    bb_re = f_re[..., None] * br - f_im[..., None] * bi
    bb_im = f_re[..., None] * bi + f_im[..., None] * br
    bu_re = jnp.einsum('blgj,gnj->blgn', ug, bb_re)
    bu_im = jnp.einsum('blgj,gnj->blgn', ug, bb_im)
    a_r = jnp.broadcast_to(abar_re, bu_re.shape)
    a_i = jnp.broadcast_to(abar_im, bu_re.shape)

    def combine(e1, e2):
        a1r, a1i, b1r, b1i = e1
        a2r, a2i, b2r, b2i = e2
        return (a2r * a1r - a2i * a1i,
                a2r * a1i + a2i * a1r,
                a2r * b1r - a2i * b1i + b2r,
                a2r * b1i + a2i * b1r + b2i)

    pr, pi, hr, hi = lax.associative_scan(combine, (a_r, a_i, bu_re, bu_im), axis=1)
    h0r = h0_re.astype(f32)[:, None]
    h0i = h0_im.astype(f32)[:, None]
    h_re = pr * h0r - pi * h0i + hr
    h_im = pr * h0i + pi * h0r + hi
    y = (jnp.einsum('gjn,blgn->blgj', c_re.astype(f32), h_re)
         - jnp.einsum('gjn,blgn->blgj', c_im.astype(f32), h_im))
    y = y.reshape(bsz, length, D_S5) + d_skip.astype(f32) * uf
    return y, h_re[:, -1], h_im[:, -1]


def hybrid_layer(x, s_gla0, s5r0, s5i0, segments,
                 g_pre_mix, w_in, w_gk2, b_gk, gla_norm,
                 s5_a_re, s5_a_im, s5_b_re, s5_b_im, s5_c_re, s5_c_im, s5_d, s5_log_dt,
                 w_s5_glu, s5_norm, w_o, g_post_mix, g_pre_ffn, w_gate, w_up, w_down, g_post_ffn):
    f32 = jnp.float32
    bsz, length, _ = x.shape
    h = rms_norm(x, g_pre_mix)
    proj = h @ w_in
    cuts = [GLA_KDIM, 2 * GLA_KDIM, 2 * GLA_KDIM + D_GLA, 2 * GLA_KDIM + 2 * D_GLA,
            2 * GLA_KDIM + 2 * D_GLA + GLA_GATE_RANK]
    q, k, v, g, gk_lr, u = jnp.split(proj, cuts, axis=-1)

    lg = jax.nn.log_sigmoid((gk_lr @ w_gk2 + b_gk).astype(f32)) / GLA_GATE_NORM
    qh = q.astype(f32).reshape(bsz, length, GLA_HEADS, GLA_DK) * (GLA_DK ** -0.5)
    kh = k.astype(f32).reshape(bsz, length, GLA_HEADS, GLA_DK)
    vh = v.astype(f32).reshape(bsz, length, GLA_HEADS, GLA_DV)
    lgh = lg.reshape(bsz, length, GLA_HEADS, GLA_DK)
    S = s_gla0.astype(f32)
    outs = []
    start = 0
    for seg_len, chunk in segments:
        o, S = gla_chunked(qh[:, start:start + seg_len], kh[:, start:start + seg_len],
                           vh[:, start:start + seg_len], lgh[:, start:start + seg_len], S, chunk)
        outs.append(o)
        start += seg_len
    o_gla = jnp.concatenate(outs, axis=1)
    o_gla = rms_norm(o_gla, gla_norm).reshape(bsz, length, D_GLA)
    o_gla = (o_gla * jax.nn.silu(g.astype(f32))).astype(x.dtype)

    y5, h_re, h_im = s5_scan(u, s5r0, s5i0, s5_a_re, s5_a_im, s5_b_re, s5_b_im,
                             s5_c_re, s5_c_im, s5_d, s5_log_dt)
    y5 = jax.nn.gelu(y5)
    y5 = y5 * jax.nn.sigmoid(y5 @ w_s5_glu.astype(f32))
    y5 = rms_norm(y5, s5_norm).astype(x.dtype)

    mix = jnp.concatenate([o_gla, y5], axis=-1) @ w_o
    x = x + rms_norm(mix, g_post_mix)

    h = rms_norm(x, g_pre_ffn)
    f = (jax.nn.silu(h @ w_gate) * (h @ w_up)) @ w_down
    x = x + rms_norm(f, g_post_ffn)
    return x, S, h_re, h_im


def setup_inputs(seed: int = 0) -> dict:
    key = jax.random.key(seed)
    ks = iter(jax.random.split(key, 40))
    nrm = lambda shape, scale: jax.random.normal(next(ks), shape, jnp.float32) * scale
    gain = lambda shape: 1.0 + nrm(shape, 0.01)
    L = DEPTH
    n_idx = jnp.arange(S5_STATE, dtype=jnp.float32)
    return {
        "x_prompt": nrm((BATCH, SEQ, D_MODEL), 1.0),
        "x_sample": nrm((DEC_BATCH, DEC_SEQ, D_MODEL), 1.0),
        "state_gla": nrm((L, DEC_BATCH, GLA_HEADS, GLA_DK, GLA_DV), 0.3),
        "state_s5_re": nrm((L, DEC_BATCH, S5_GROUPS, S5_STATE), 0.1),
        "state_s5_im": nrm((L, DEC_BATCH, S5_GROUPS, S5_STATE), 0.1),
        "meta_tokens": nrm((N_META, D_MODEL), 1.0),
        "g_pre_mix": gain((L, D_MODEL)),
        "w_in": nrm((L, D_MODEL, D_IN), D_MODEL ** -0.5),
        "w_gk2": nrm((L, GLA_GATE_RANK, GLA_KDIM), GLA_GATE_RANK ** -0.5),
        "b_gk": nrm((L, GLA_KDIM), 0.01),
        "gla_norm": gain((L, GLA_DV)),
        "s5_a_re": -0.5 + nrm((L, S5_GROUPS, S5_STATE), 0.01),
        "s5_a_im": math.pi * n_idx + nrm((L, S5_GROUPS, S5_STATE), 0.01),
        "s5_b_re": nrm((L, S5_GROUPS, S5_STATE, S5_GROUP), (2.0 * S5_GROUP) ** -0.5),
        "s5_b_im": nrm((L, S5_GROUPS, S5_STATE, S5_GROUP), (2.0 * S5_GROUP) ** -0.5),
        "s5_c_re": nrm((L, S5_GROUPS, S5_GROUP, S5_STATE), (2.0 * S5_STATE) ** -0.5),
        "s5_c_im": nrm((L, S5_GROUPS, S5_GROUP, S5_STATE), (2.0 * S5_STATE) ** -0.5),
        "s5_d": nrm((L, D_S5), 0.5),
        "s5_log_dt": jax.random.uniform(next(ks), (L, S5_GROUPS), jnp.float32,
                                         math.log(1e-3), math.log(1e-1)),
        "w_s5_glu": nrm((L, D_S5, D_S5), D_S5 ** -0.5),
        "s5_norm": gain((L, D_S5)),
        "w_o": nrm((L, D_MIX, D_MODEL), D_MIX ** -0.5),
        "g_post_mix": gain((L, D_MODEL)),
        "g_pre_ffn": gain((L, D_MODEL)),
        "w_gate": nrm((L, D_MODEL, D_FF), D_MODEL ** -0.5),
        "w_up": nrm((L, D_MODEL, D_FF), D_MODEL ** -0.5),
        "w_down": nrm((L, D_FF, D_MODEL), D_FF ** -0.5),
        "g_post_ffn": gain((L, D_MODEL)),
    }


def reference(x_prompt, x_sample, state_gla, state_s5_re, state_s5_im, meta_tokens,
              g_pre_mix, w_in, w_gk2, b_gk, gla_norm,
              s5_a_re, s5_a_im, s5_b_re, s5_b_im, s5_c_re, s5_c_im, s5_d, s5_log_dt,
              w_s5_glu, s5_norm, w_o, g_post_mix, g_pre_ffn, w_gate, w_up, w_down, g_post_ffn):
    bp, seq_p, _ = x_prompt.shape
    bs, seq_s, _ = x_sample.shape
    meta = jnp.broadcast_to(meta_tokens.astype(x_prompt.dtype)[None], (bp, N_META, D_MODEL))
    xp = jnp.concatenate([meta, x_prompt], axis=1)
    xs = x_sample
    seg_prompt = ((N_META, N_META), (seq_p, GLA_CHUNK))
    seg_sample = ((seq_s, seq_s),)
    zeros_gla = jnp.zeros((bp, GLA_HEADS, GLA_DK, GLA_DV), jnp.float32)
    zeros_s5 = jnp.zeros((bp, S5_GROUPS, S5_STATE), jnp.float32)
    gp_l, rp_l, ip_l, gs_l, rs_l, is_l = [], [], [], [], [], []
    for l in range(DEPTH):
        w = (g_pre_mix[l], w_in[l], w_gk2[l], b_gk[l], gla_norm[l],
             s5_a_re[l], s5_a_im[l], s5_b_re[l], s5_b_im[l], s5_c_re[l], s5_c_im[l],
             s5_d[l], s5_log_dt[l], w_s5_glu[l], s5_norm[l], w_o[l], g_post_mix[l],
             g_pre_ffn[l], w_gate[l], w_up[l], w_down[l], g_post_ffn[l])
        xp, sg, sr, si = hybrid_layer(xp, zeros_gla, zeros_s5, zeros_s5, seg_prompt, *w)
        gp_l.append(sg); rp_l.append(sr); ip_l.append(si)
        xs, sg, sr, si = hybrid_layer(xs, state_gla[l], state_s5_re[l], state_s5_im[l],
                                      seg_sample, *w)
        gs_l.append(sg); rs_l.append(sr); is_l.append(si)
    y_prompt = xp[:, N_META:]
    y_sample = xs
    new_gla_prompt = jnp.stack(gp_l)
    new_s5_re_prompt = jnp.stack(rp_l)
    new_s5_im_prompt = jnp.stack(ip_l)
    new_gla_sample = jnp.stack(gs_l)
    new_s5_re_sample = jnp.stack(rs_l)
    new_s5_im_sample = jnp.stack(is_l)
    return (y_prompt, y_sample, new_gla_prompt, new_s5_re_prompt, new_s5_im_prompt,
            new_gla_sample, new_s5_re_sample, new_s5_im_sample)
```

```cpp
#include <hip/hip_runtime.h>
#include <hip/hip_bf16.h>
#include <hip/hip_cooperative_groups.h>
#include <cstdio>
namespace cg = cooperative_groups;

#ifndef SINGLE_LAUNCH
#define SINGLE_LAUNCH 1
#endif

#define DEVINL __device__ __forceinline__
typedef unsigned short u16;
using bf16x8 = __attribute__((ext_vector_type(8))) short;
using f32x4 = __attribute__((ext_vector_type(4))) float;

constexpr int DM = 1024;
constexpr int NB = 8, SEQ = 2048, NMETA = 16, LP = SEQ + NMETA;
constexpr int MPROMPT = NB * LP;
constexpr int SB = 128, SS = 8, MSAMPLE = SB * SS;
constexpr int M = MPROMPT + MSAMPLE;
constexpr int MT = M / 128;
constexpr int DIN = 2064;
constexpr int N1 = 2176;
constexpr int DFF = 2816;
constexpr int LDT = M + 64;
constexpr int NCH_P = NB * 4 * 33;
constexpr int NCH = NCH_P + SB * 4;
constexpr float EPS = 1e-6f;

constexpr size_t al256(size_t x) { return (x + 255) & ~(size_t)255; }
constexpr size_t OFF_W1T = 0;
constexpr size_t OFF_WGLUT = OFF_W1T + al256((size_t)N1 * 1024 * 2);
constexpr size_t OFF_WOT = OFF_WGLUT + al256((size_t)512 * 512 * 2);
constexpr size_t OFF_WGUT = OFF_WOT + al256((size_t)1024 * 1024 * 2);
constexpr size_t OFF_WDT = OFF_WGUT + al256((size_t)5632 * 1024 * 2);
constexpr size_t OFF_SMALL = OFF_WDT + al256((size_t)1024 * DFF * 2);
constexpr size_t OFF_RSTD0 = OFF_SMALL;
constexpr size_t OFF_SS5 = OFF_RSTD0 + al256((size_t)M * 4);
constexpr size_t OFF_SSMIX = OFF_SS5 + al256((size_t)M * 4);
constexpr size_t OFF_SSF = OFF_SSMIX + al256((size_t)M * 4);
constexpr size_t OFF_RSTD1 = OFF_SSF + al256((size_t)M * 4);
constexpr size_t OFF_DECAY = OFF_RSTD1 + al256((size_t)M * 4);
constexpr size_t OFF_HEND = OFF_DECAY + al256((size_t)NCH * 64 * 4);
constexpr size_t OFF_ABAR = OFF_HEND + al256((size_t)256 * 7 * 64 * 2 * 4);
constexpr size_t OFF_APW = OFF_ABAR + al256((size_t)32 * 64 * 2 * 4);
constexpr size_t OFF_BBT = OFF_APW + al256((size_t)32 * 64 * 4 * 4);
constexpr size_t OFF_CT = OFF_BBT + al256((size_t)32 * 128 * 16 * 2);
constexpr size_t OFF_GK = OFF_CT + al256((size_t)32 * 16 * 128 * 2);
constexpr size_t OFF_BAR = OFF_GK + al256((size_t)M * 16 * 4);
constexpr size_t OFF_SS5P = OFF_BAR + al256((size_t)3456 * 4);
constexpr size_t OFF_RA = OFF_SS5P + al256((size_t)4 * M * 2 * 4);
constexpr size_t SZ_RA = al256((size_t)NCH * 8192 * 4);
constexpr size_t OFF_DS = OFF_RA, OFF_MIXO = OFF_RA;
constexpr size_t OFF_RB = OFF_RA + SZ_RA;
constexpr size_t OFF_QK = OFF_RB;
constexpr size_t OFF_KT = OFF_QK + al256((size_t)M * 512 * 2);
constexpr size_t OFF_VT = OFF_KT + al256((size_t)256 * LDT * 2);
constexpr size_t OFF_GB = OFF_VT + al256((size_t)512 * LDT * 2);
constexpr size_t OFF_UB = OFF_GB + al256((size_t)M * 512 * 2);
constexpr size_t OFF_RC = OFF_UB + al256((size_t)M * 512 * 2);
constexpr size_t OFF_X1B = OFF_RB;
constexpr size_t OFF_FB = OFF_RA;
constexpr size_t OFF_ACTB = OFF_RB + al256((size_t)M * 1024 * 2);
constexpr size_t OFF_SPT = OFF_RC;
constexpr size_t OFF_MIXIN = OFF_SPT + al256((size_t)NCH * 8192 * 2);
constexpr size_t OFF_YG = OFF_MIXIN + al256((size_t)M * 1024 * 2);
constexpr size_t OFF_XB = OFF_MIXIN;
constexpr size_t OFF_BCUM = al256(OFF_MIXIN + al256((size_t)M * 1024 * 2) + (size_t)M * 512 * 2);
static_assert(OFF_BCUM + (size_t)NCH * 4096 * 4 <= (size_t)268435456, "bcum fits the workspace tail");
constexpr size_t OFF_FB1 = al256(OFF_ACTB + (size_t)M * DFF * 2);
constexpr size_t WS_TOTAL = OFF_FB1 + al256((size_t)M * 1024 * 2);
static_assert(OFF_YG + al256((size_t)M * 512 * 2) <= WS_TOTAL, "yg fits");
static_assert(WS_TOTAL <= (size_t)268435456, "workspace too large");
static_assert((size_t)M * 1024 * 2 <= SZ_RA, "xb/mixo fit");

constexpr size_t OUT_YP = 0;
constexpr size_t OUT_YS = OUT_YP + (size_t)NB * SEQ * DM;
constexpr size_t OUT_GP = OUT_YS + (size_t)SB * SS * DM;
constexpr size_t OUT_RP = OUT_GP + (size_t)NB * 4 * 64 * 128;
constexpr size_t OUT_IP = OUT_RP + (size_t)NB * 32 * 64;
constexpr size_t OUT_GS = OUT_IP + (size_t)NB * 32 * 64;
constexpr size_t OUT_RS = OUT_GS + (size_t)SB * 4 * 64 * 128;
constexpr size_t OUT_IS = OUT_RS + (size_t)SB * 32 * 64;

struct Params {
  const float *x_prompt, *x_sample, *state_gla, *s5r0, *s5i0, *meta, *g_pre_mix, *w_in, *w_gk2, *b_gk, *gla_norm;
  const float *a_re, *a_im, *b_re, *b_im, *c_re, *c_im, *s5_d, *log_dt, *w_glu, *s5_norm, *w_o, *g_post_mix;
  const float *g_pre_ffn, *w_gate, *w_up, *w_down, *g_post_ffn;
  float* out;
  char* ws;
};

DEVINL int tidx() { int t = threadIdx.x; asm volatile("" : "+v"(t)); return t; }
DEVINL int bidx() { int t = blockIdx.x; asm volatile("" : "+s"(t)); return t; }
DEVINL u16 f2bf(float f) { return (u16)((__float_as_uint(f) + 0x8000u) >> 16); }
DEVINL float bf2f(u16 h) { return __uint_as_float(((unsigned)h) << 16); }
DEVINL unsigned pack2(float a, float b) {
  return __builtin_amdgcn_perm(__float_as_uint(b) + 0x8000u, __float_as_uint(a) + 0x8000u, 0x07060302u);
}
template <int CTRL> DEVINL float dpp_f(float v) {
  return __builtin_bit_cast(float, __builtin_amdgcn_update_dpp(0, __builtin_bit_cast(int, v), CTRL, 0xF, 0xF, true));
}
DEVINL float lane_xor1(float v) { return dpp_f<0xB1>(v); }
DEVINL float red16(float v) {
  v += dpp_f<0xB1>(v);
  v += dpp_f<0x4E>(v);
  v += dpp_f<0x141>(v);
  v += dpp_f<0x140>(v);
  return v;
}
DEVINL void store_pairs(u16* base, size_t ld, int rb, int col, float v0, float v1, float v2, float v3) {
  const float p0 = lane_xor1(v0), p1 = lane_xor1(v1), p2 = lane_xor1(v2), p3 = lane_xor1(v3);
  const bool odd = (col & 1) != 0;
  const int r0 = odd ? rb + 2 : rb, c0 = col & ~1;
  const unsigned w0 = odd ? pack2(p2, v2) : pack2(v0, p0);
  const unsigned w1 = odd ? pack2(p3, v3) : pack2(v1, p1);
  *(unsigned*)(base + (size_t)r0 * ld + c0) = w0;
  *(unsigned*)(base + (size_t)(r0 + 1) * ld + c0) = w1;
}
DEVINL float sigmoidf_(float x) { return __builtin_amdgcn_rcpf(1.f + __expf(-x)); }
DEVINL float siluf_(float x) { return x * __builtin_amdgcn_rcpf(1.f + __expf(-x)); }
DEVINL float geluf_(float x) {
  float u = 0.7978845608028654f * (x + 0.044715f * x * x * x);
  float t = 1.f - 2.f * __builtin_amdgcn_rcpf(__expf(2.f * u) + 1.f);
  return 0.5f * x * (1.f + t);
}
DEVINL float logsigf_(float z) { return fminf(z, 0.f) - __logf(1.f + __expf(-fabsf(z))); }
DEVINL f32x4 mfma16(bf16x8 a, bf16x8 b, f32x4 c) { return __builtin_amdgcn_mfma_f32_16x16x32_bf16(a, b, c, 0, 0, 0); }
DEVINL void glds16(const void* g, void* l) {
  __builtin_amdgcn_global_load_lds((const unsigned*)g, (unsigned*)l, 16, 0, 0);
}
DEVINL int ridx(int r) { return ((r >> 4) << 5) | (r & 15); }
constexpr size_t OFF_RSTD1X = OFF_SSF;
static_assert(OFF_SS5 == OFF_RSTD0 + al256((size_t)M * 4) && OFF_RSTD1 == OFF_SSF + al256((size_t)M * 4), "padded rstd slots");
DEVINL const float* xrow_ptr(const Params& p, int r) {
  if (r < MPROMPT) {
    int b = r / LP, t = r - b * LP;
    return (t < NMETA) ? (p.meta + (size_t)t * DM) : (p.x_prompt + ((size_t)b * SEQ + (t - NMETA)) * DM);
  }
  return p.x_sample + (size_t)(r - MPROMPT) * DM;
}
DEVINL float* outrow_ptr(const Params& p, int r) {
  if (r < MPROMPT) {
    int b = r / LP, t = r - b * LP;
    return (t < NMETA) ? nullptr : (p.out + OUT_YP + ((size_t)b * SEQ + (t - NMETA)) * DM);
  }
  return p.out + OUT_YS + (size_t)(r - MPROMPT) * DM;
}

DEVINL void tr_tile(const Params& p, char* smem, int kind, int nt, int kt) {
  float* T = (float*)smem;
  const int tid = tidx();
  const int n0 = nt * 64, k0 = kt * 64;
  const int nl = tid & 63, kq = tid >> 6;
  const int n = n0 + nl;
  const float* src = nullptr; int ld = 0, col = 0; bool valid = true; float cs = 1.f;
  const float* ksc = nullptr; int K = 1024; u16* dst = nullptr;
  if (kind == 0) {
    src = p.w_in; ld = DIN; ksc = p.g_pre_mix; dst = (u16*)(p.ws + OFF_W1T);
    if (n < 256) { col = n; cs = 0.125f; }
    else if (n < 1536) col = n;
    else if (n < 2048) col = 1552 + (n - 1536);
    else if (n < 2064) col = 1536 + (n - 2048);
    else { valid = false; col = 0; }
  } else if (kind == 1) {
    src = p.w_glu; ld = 512; col = n; K = 512; dst = (u16*)(p.ws + OFF_WGLUT);
  } else if (kind == 2) {
    src = p.w_o; ld = 1024; col = n; dst = (u16*)(p.ws + OFF_WOT);
  } else if (kind == 3) {
    int Tt = n >> 7, loc = n & 127, wn = loc >> 6, nf = (loc >> 4) & 3, c = loc & 15;
    int hidden = Tt * 64 + wn * 32 + (nf & 1) * 16 + c;
    src = (nf >= 2) ? p.w_up : p.w_gate; ld = DFF; col = hidden; ksc = p.g_pre_ffn; dst = (u16*)(p.ws + OFF_WGUT);
  } else {
    src = p.w_down; ld = 1024; col = n; K = DFF; dst = (u16*)(p.ws + OFF_WDT);
  }
  __syncthreads();
#pragma unroll 4
  for (int i = 0; i < 16; ++i) {
    int k = kq * 16 + i;
    float v = valid ? src[(size_t)(k0 + k) * ld + col] : 0.f;
    if (ksc) v *= ksc[k0 + k];
    if (kind == 2 && (k0 + k) >= 512) v *= p.s5_norm[k0 + k - 512];
    T[k * 65 + nl] = v * cs;
  }
  __syncthreads();
  const int n2 = tid >> 2, kseg = (tid & 3) * 16;
  unsigned w[8];
#pragma unroll
  for (int i = 0; i < 8; ++i) w[i] = pack2(T[(kseg + 2 * i) * 65 + n2], T[(kseg + 2 * i + 1) * 65 + n2]);
  uint4* d = (uint4*)(dst + (size_t)(n0 + n2) * K + k0 + kseg);
  d[0] = make_uint4(w[0], w[1], w[2], w[3]);
  d[1] = make_uint4(w[4], w[5], w[6], w[7]);
}

DEVINL void csq(float& r, float& i) { float nr = r * r - i * i, ni = 2.f * r * i; r = nr; i = ni; }

DEVINL void s5_param(const Params& p, int idx) {
  const int g = idx >> 6, n = idx & 63;
  float lre = fminf(p.a_re[idx], -1e-4f), lim = p.a_im[idx];
  float dt = expf(p.log_dt[g]);
  float mag = expf(lre * dt);
  float ar = mag * cosf(lim * dt), ai = mag * sinf(lim * dt);
  float den = lre * lre + lim * lim;
  float nr = ar - 1.f, ni = ai;
  float fr = (nr * lre + ni * lim) / den, fi = (ni * lre - nr * lim) / den;
  float* abar = (float*)(p.ws + OFF_ABAR);
  abar[idx * 2] = ar; abar[idx * 2 + 1] = ai;
  float p16r = ar, p16i = ai;
  for (int e = 0; e < 4; ++e) csq(p16r, p16i);
  float p256r = p16r, p256i = p16i;
  for (int e = 0; e < 4; ++e) csq(p256r, p256i);
  float* apw = (float*)(p.ws + OFF_APW);
  apw[idx * 4 + 0] = p256r; apw[idx * 4 + 1] = p256i;
  apw[idx * 4 + 2] = p256r * p16r - p256i * p16i; apw[idx * 4 + 3] = p256r * p16i + p256i * p16r;
  u16* bbt = (u16*)(p.ws + OFF_BBT);
  u16* ct = (u16*)(p.ws + OFF_CT);
  for (int j = 0; j < 16; ++j) {
    float br = p.b_re[(size_t)idx * 16 + j], bi = p.b_im[(size_t)idx * 16 + j];
    bbt[((size_t)g * 128 + 2 * n) * 16 + j] = f2bf(fr * br - fi * bi);
    bbt[((size_t)g * 128 + 2 * n + 1) * 16 + j] = f2bf(fr * bi + fi * br);
    ct[((size_t)g * 16 + j) * 128 + 2 * n] = f2bf(p.c_re[((size_t)g * 16 + j) * 64 + n]);
    ct[((size_t)g * 16 + j) * 128 + 2 * n + 1] = f2bf(-p.c_im[((size_t)g * 16 + j) * 64 + n]);
  }
}

template <int R>
DEVINL void xrow_prep(const Params& p, int r0) {
  const int lane = tidx() & 63;
  float4 v[R][4];
#pragma unroll
  for (int q = 0; q < R; ++q) {
    const float* x = xrow_ptr(p, r0 + q);
#pragma unroll
    for (int i = 0; i < 4; ++i) v[q][i] = *(const float4*)(x + i * 256 + lane * 4);
  }
#pragma unroll
  for (int q = 0; q < R; ++q) {
    u16* xb = (u16*)(p.ws + OFF_XB) + (size_t)(r0 + q) * DM;
    float ss = 0.f;
#pragma unroll
    for (int i = 0; i < 4; ++i) {
      const float4 a = v[q][i];
      ss += a.x * a.x + a.y * a.y + a.z * a.z + a.w * a.w;
      *(uint2*)(xb + i * 256 + lane * 4) = make_uint2(pack2(a.x, a.y), pack2(a.z, a.w));
    }
    ss = red16(ss); ss += __shfl_xor(ss, 16); ss += __shfl_xor(ss, 32);
    if (lane == 0) ((float*)(p.ws + OFF_RSTD0))[ridx(r0 + q)] = rsqrtf(ss * (1.f / DM) + EPS);
  }
}

constexpr int TR0 = 34 * 16, TR1 = 8 * 8, TR2 = 16 * 16, TR3 = 88 * 16, TR4 = 16 * 44;
constexpr int NTR = TR0 + TR1 + TR2 + TR3 + TR4;
constexpr int NXROW_ITEMS = M / 16;
constexpr int P0_ITEMS = NTR + NXROW_ITEMS + 8  ;

constexpr int NTR_A = TR0 + TR1 + TR2;
DEVINL void phase0(const Params& p, char* smem) {
  for (int it = bidx(); it < NTR_A + NXROW_ITEMS + 8; it += gridDim.x) {
    if (it < NTR_A) {
      int t = it;
      if (t < TR0) { tr_tile(p, smem, 0, t / 16, t % 16); continue; } t -= TR0;
      if (t < TR1) { tr_tile(p, smem, 1, t / 8, t % 8); continue; } t -= TR1;
      tr_tile(p, smem, 2, t / 16, t % 16);
    } else if (it < NTR_A + NXROW_ITEMS) {
      xrow_prep<4>(p, (it - NTR_A) * 16 + (tidx() >> 6) * 4);
    } else {
      s5_param(p, (it - NTR_A - NXROW_ITEMS) * 256 + tidx());
    }
  }
}
DEVINL void ffn_weight_tile(const Params& p, char* smem, int t) {
  if (t < TR3) tr_tile(p, smem, 3, t / 16, t % 16);
  else tr_tile(p, smem, 4, (t - TR3) / 44, (t - TR3) % 44);
}

DEVINL void gemm_issue0(const u16* __restrict__ A, int lda, const u16* __restrict__ Bt, int ldb,
                        int m0, int n0, int k0, char* smem, bool sync) {
  const int tid = tidx(), wid = tid >> 6;
  if (sync) __syncthreads();
#pragma unroll
  for (int i = 0; i < 4; ++i) {
    int s = i * 256 + tid, r = s >> 3, c = (s & 7) ^ ((r >> 1) & 7);
    glds16(A + (size_t)(m0 + r) * lda + k0 + c * 8, smem + i * 4096 + wid * 1024);
    glds16(Bt + (size_t)(n0 + r) * ldb + k0 + c * 8, smem + 16384 + i * 4096 + wid * 1024);
  }
}

DEVINL void gemm_loop(f32x4 (&acc)[4][4], const u16* __restrict__ A, int lda, const u16* __restrict__ Bt, int ldb,
                      int m0, int n0, int k0, int nk, char* smem, bool preissued = false) {
  const int tid = tidx(), wid = tid >> 6, lane = tid & 63;
  const int wr = wid >> 1, wc = wid & 1;
  const u16* ga[4]; const u16* gb[4];
#pragma unroll
  for (int i = 0; i < 4; ++i) {
    int s = i * 256 + tid, r = s >> 3, c = (s & 7) ^ ((r >> 1) & 7);
    ga[i] = A + (size_t)(m0 + r) * lda + k0 + c * 8;
    gb[i] = Bt + (size_t)(n0 + r) * ldb + k0 + c * 8;
  }
  const int fr = lane & 15, fq = lane >> 4;
  if (!preissued) {
    __syncthreads();
#pragma unroll
    for (int i = 0; i < 4; ++i) {
      glds16(ga[i], smem + i * 4096 + wid * 1024);
      glds16(gb[i], smem + 16384 + i * 4096 + wid * 1024);
    }
  }
  for (int kt = 0; kt < nk; ++kt) {
    asm volatile("s_waitcnt vmcnt(0)" ::: "memory");
    __syncthreads();
    char* cur = smem + (kt & 1) * 32768;
    if (kt + 1 < nk) {
      char* nxt = smem + ((kt + 1) & 1) * 32768;
#pragma unroll
      for (int i = 0; i < 4; ++i) {
        glds16(ga[i] + (kt + 1) * 64, nxt + i * 4096 + wid * 1024);
        glds16(gb[i] + (kt + 1) * 64, nxt + 16384 + i * 4096 + wid * 1024);
      }
    }
    bf16x8 af[2][4], bfr[2][4];
#pragma unroll
    for (int ks = 0; ks < 2; ++ks)
#pragma unroll
      for (int f = 0; f < 4; ++f) {
        int ra = wr * 64 + f * 16 + fr, rb = wc * 64 + f * 16 + fr;
        int ch = ks * 4 + fq;
        af[ks][f] = *(const bf16x8*)(cur + ra * 128 + ((ch ^ ((ra >> 1) & 7)) << 4));
        bfr[ks][f] = *(const bf16x8*)(cur + 16384 + rb * 128 + ((ch ^ ((rb >> 1) & 7)) << 4));
      }
    __builtin_amdgcn_sched_barrier(0);
#pragma unroll
    for (int ks = 0; ks < 2; ++ks)
#pragma unroll
      for (int mf = 0; mf < 4; ++mf)
#pragma unroll
        for (int nf = 0; nf < 4; ++nf) acc[mf][nf] = mfma16(af[ks][mf], bfr[ks][nf], acc[mf][nf]);
  }
}

DEVINL void zero_acc(f32x4 (&acc)[4][4]) {
#pragma unroll
  for (int a = 0; a < 4; ++a)
#pragma unroll
    for (int b = 0; b < 4; ++b) acc[a][b] = f32x4{0.f, 0.f, 0.f, 0.f};
}

DEVINL void row_ss_atomic(float s, float* dst) {
  s += __shfl_xor(s, 1); s += __shfl_xor(s, 2); s += __shfl_xor(s, 4); s += __shfl_xor(s, 8);
  if ((tidx() & 15) == 0) unsafeAtomicAdd(dst, s);
}

DEVINL void p1_tile(const Params& p, char* smem, int mt, int nt, bool first, bool hn, int mtn, int ntn) {
  f32x4 acc[4][4]; zero_acc(acc);
  const int m0 = mt * 128, n0 = nt * 128;
  const u16* Ap = (const u16*)(p.ws + OFF_XB); const u16* Bp = (const u16*)(p.ws + OFF_W1T);
  if (first) gemm_issue0(Ap, 1024, Bp, 1024, m0, n0, 0, smem, true);
  gemm_loop(acc, Ap, 1024, Bp, 1024, m0, n0, 0, 16, smem, true);
  const int lane = tidx() & 63, wid = tidx() >> 6, wr = wid >> 1, wc = wid & 1;
  const float* rstd0 = (const float*)(p.ws + OFF_RSTD0);
  float rsa[4][4];
#pragma unroll
  for (int mf = 0; mf < 4; ++mf)
#pragma unroll
    for (int j = 0; j < 4; ++j) rsa[mf][j] = rstd0[ridx(m0 + wr * 64 + mf * 16 + (lane >> 4) * 4) + j];
  if (hn) gemm_issue0(Ap, 1024, Bp, 1024, mtn * 128, ntn * 128, 0, smem, false);
  u16* qk = (u16*)(p.ws + OFF_QK); u16* kT = (u16*)(p.ws + OFF_KT); u16* vT = (u16*)(p.ws + OFF_VT);
  u16* gb = (u16*)(p.ws + OFF_GB); u16* ub = (u16*)(p.ws + OFF_UB); float* gk = (float*)(p.ws + OFF_GK);
#pragma unroll
  for (int mf = 0; mf < 4; ++mf) {
    const int rb = m0 + wr * 64 + mf * 16 + (lane >> 4) * 4;
    float rs[4];
#pragma unroll
    for (int j = 0; j < 4; ++j) rs[j] = rsa[mf][j];
#pragma unroll
    for (int nf = 0; nf < 4; ++nf) {
      const int col = n0 + wc * 64 + nf * 16 + (lane & 15);
      float v[4];
#pragma unroll
      for (int j = 0; j < 4; ++j) v[j] = acc[mf][nf][j] * rs[j];
      if (nt < 4) {
        store_pairs(qk, 512, rb, col, v[0], v[1], v[2], v[3]);
        if (nt >= 2) *(uint2*)(kT + (size_t)(col - 256) * LDT + rb) = make_uint2(pack2(v[0], v[1]), pack2(v[2], v[3]));
      } else if (nt < 8) {
        *(uint2*)(vT + (size_t)(col - 512) * LDT + rb) = make_uint2(pack2(v[0], v[1]), pack2(v[2], v[3]));
      } else if (nt < 12) {
        store_pairs(gb, 512, rb, col - 1024, v[0], v[1], v[2], v[3]);
      } else if (nt < 16) {
        store_pairs(ub, 512, rb, col - 1536, v[0], v[1], v[2], v[3]);
      } else if (col < 2064) {
#pragma unroll
        for (int j = 0; j < 4; ++j) gk[(size_t)(rb + j) * 16 + (col - 2048)] = v[j];
      }
    }
  }
}

DEVINL void p3_tile(const Params& p, char* smem, int mt, int nt, bool first, bool hn, int mtn, int ntn) {
  f32x4 acc[4][4]; zero_acc(acc);
  const int m0 = mt * 128, n0 = nt * 128;
  const u16* yg = (const u16*)(p.ws + OFF_YG); const u16* Bp = (const u16*)(p.ws + OFF_WGLUT);
  if (first) gemm_issue0(yg, 512, Bp, 512, m0, n0, 0, smem, true);
  gemm_loop(acc, yg, 512, Bp, 512, m0, n0, 0, 8, smem, true);
  if (hn) gemm_issue0(yg, 512, Bp, 512, mtn * 128, ntn * 128, 0, smem, false);
  const int lane = tidx() & 63, wid = tidx() >> 6, wr = wid >> 1, wc = wid & 1;
  u16* mixin = (u16*)(p.ws + OFF_MIXIN);
#pragma unroll
  for (int mf = 0; mf < 4; ++mf) {
    const int rb = m0 + wr * 64 + mf * 16 + (lane >> 4) * 4;
    float ssq[4] = {0.f, 0.f, 0.f, 0.f};
#pragma unroll
    for (int nf = 0; nf < 4; ++nf) {
      const int col = n0 + wc * 64 + nf * 16 + (lane & 15);
      float val[4];
#pragma unroll
      for (int j = 0; j < 4; ++j) {
        val[j] = bf2f(yg[(size_t)(rb + j) * 512 + col]) * sigmoidf_(acc[mf][nf][j]);
        ssq[j] += val[j] * val[j];
      }
      store_pairs(mixin, 1024, rb, 512 + col, val[0], val[1], val[2], val[3]);
    }
    {
      float* ss5p = (float*)(p.ws + OFF_SS5P);
#pragma unroll
      for (int j = 0; j < 4; ++j) {
        const float v = red16(ssq[j]);
        if ((lane & 15) == 0) ss5p[((size_t)nt * M + rb + j) * 2 + wc] = v;
      }
    }
  }
}

DEVINL void p4_tile(const Params& p, char* smem, int mt, int nt, bool first, bool hn, int mtn, int ntn) {
  f32x4 acc[4][4]; zero_acc(acc);
  const int m0 = mt * 128, n0 = nt * 128;
  const u16* mixin = (const u16*)(p.ws + OFF_MIXIN); const u16* wot = (const u16*)(p.ws + OFF_WOT);
  if (first) gemm_issue0(mixin, 1024, wot, 1024, m0, n0, 512, smem, true);
  gemm_loop(acc, mixin, 1024, wot, 1024, m0, n0, 512, 8, smem, true);
  const int lane = tidx() & 63, wid = tidx() >> 6, wr = wid >> 1, wc = wid & 1;
  {
    const int tid = tidx(), row = tid >> 1, half = tid & 1;
    const float* ss5p = (const float*)(p.ws + OFF_SS5P);
    float ssq = 0.f;
#pragma unroll
    for (int q = 0; q < 2; ++q) {
      const float2 v = *(const float2*)(ss5p + ((size_t)(half * 2 + q) * M + m0 + row) * 2);
      ssq += v.x + v.y;
    }
    ssq += lane_xor1(ssq);
    __syncthreads();
    float* rs5 = (float*)smem;
    if (half == 0) rs5[row] = rsqrtf(ssq * (1.f / 512.f) + EPS);
    __syncthreads();
#pragma unroll
    for (int mf = 0; mf < 4; ++mf) {
      const int rl = wr * 64 + mf * 16 + (lane >> 4) * 4;
#pragma unroll
      for (int j = 0; j < 4; ++j) {
        const float rs = rs5[rl + j];
#pragma unroll
        for (int nf = 0; nf < 4; ++nf) acc[mf][nf][j] *= rs;
      }
    }
  }
  gemm_loop(acc, mixin, 1024, wot, 1024, m0, n0, 0, 8, smem);
  if (hn) gemm_issue0(mixin, 1024, wot, 1024, mtn * 128, ntn * 128, 512, smem, false);
  u16* mixo = (u16*)(p.ws + OFF_MIXO);
#pragma unroll
  for (int mf = 0; mf < 4; ++mf) {
    const int rb = m0 + wr * 64 + mf * 16 + (lane >> 4) * 4;
#pragma unroll
    for (int nf = 0; nf < 4; ++nf) {
      const int col = n0 + wc * 64 + nf * 16 + (lane & 15);
      store_pairs(mixo, 1024, rb, col, acc[mf][nf][0], acc[mf][nf][1], acc[mf][nf][2], acc[mf][nf][3]);
    }
  }
}

DEVINL void p6_tile(const Params& p, char* smem, int mt, int nt, bool first, bool hn, int mtn, int ntn) {
  f32x4 acc[4][4]; zero_acc(acc);
  const int m0 = mt * 128, n0 = nt * 128;
  const u16* Ap = (const u16*)(p.ws + OFF_X1B); const u16* Bp = (const u16*)(p.ws + OFF_WGUT);
  if (first) gemm_issue0(Ap, 1024, Bp, 1024, m0, n0, 0, smem, true);
  gemm_loop(acc, Ap, 1024, Bp, 1024, m0, n0, 0, 16, smem, true);
  const int lane = tidx() & 63, wid = tidx() >> 6, wr = wid >> 1, wc = wid & 1;
  const float* rstd1 = (const float*)(p.ws + OFF_RSTD1X);
  float rsa[4][4];
#pragma unroll
  for (int mf = 0; mf < 4; ++mf)
#pragma unroll
    for (int j = 0; j < 4; ++j) rsa[mf][j] = rstd1[ridx(m0 + wr * 64 + mf * 16 + (lane >> 4) * 4) + j];
  if (hn) gemm_issue0(Ap, 1024, Bp, 1024, mtn * 128, ntn * 128, 0, smem, false);
  u16* actb = (u16*)(p.ws + OFF_ACTB);
#pragma unroll
  for (int mf = 0; mf < 4; ++mf) {
    const int rb = m0 + wr * 64 + mf * 16 + (lane >> 4) * 4;
    float rs[4];
#pragma unroll
    for (int j = 0; j < 4; ++j) rs[j] = rsa[mf][j];
#pragma unroll
    for (int nf = 0; nf < 2; ++nf) {
      const int hid = nt * 64 + wc * 32 + nf * 16 + (lane & 15);
      float a[4];
#pragma unroll
      for (int j = 0; j < 4; ++j) {
        float g = acc[mf][nf][j] * rs[j], u = acc[mf][nf + 2][j] * rs[j];
        a[j] = siluf_(g) * u;
      }
      store_pairs(actb, DFF, rb, hid, a[0], a[1], a[2], a[3]);
    }
  }
}

DEVINL void p7_tile(const Params& p, char* smem, int mt, int ntp, bool first, bool hn, int mtn, int ntpn) {
  f32x4 acc[4][4]; zero_acc(acc);
  const int khalf = ntp >> 3, nt = ntp & 7;
  const int m0 = mt * 128, n0 = nt * 128;
  const u16* Ap = (const u16*)(p.ws + OFF_ACTB); const u16* Bp = (const u16*)(p.ws + OFF_WDT);
  if (first) gemm_issue0(Ap, DFF, Bp, DFF, m0, n0, khalf * (DFF / 2), smem, true);
  gemm_loop(acc, Ap, DFF, Bp, DFF, m0, n0, khalf * (DFF / 2), 22, smem, true);
  if (hn) gemm_issue0(Ap, DFF, Bp, DFF, mtn * 128, (ntpn & 7) * 128, (ntpn >> 3) * (DFF / 2), smem, false);
  const int lane = tidx() & 63, wid = tidx() >> 6, wr = wid >> 1, wc = wid & 1;
  u16* fb = (u16*)(p.ws + (khalf ? OFF_FB1 : OFF_FB));
#pragma unroll
  for (int mf = 0; mf < 4; ++mf) {
    const int rb = m0 + wr * 64 + mf * 16 + (lane >> 4) * 4;
#pragma unroll
    for (int nf = 0; nf < 4; ++nf) {
      const int col = n0 + wc * 64 + nf * 16 + (lane & 15);
      store_pairs(fb, 1024, rb, col, acc[mf][nf][0], acc[mf][nf][1], acc[mf][nf][2], acc[mf][nf][3]);
    }
  }
}

struct ChunkInfo { int r0, T, h; };
DEVINL ChunkInfo chunk_info(int item) {
  ChunkInfo ci;
  if (item < NCH_P) {
    int bh = item / 33, c = item - bh * 33, b = bh >> 2;
    ci.h = bh & 3;
    if (c == 0) { ci.r0 = b * LP; ci.T = 16; }
    else { ci.r0 = b * LP + 16 + 64 * (c - 1); ci.T = 64; }
  } else {
    int bh = item - NCH_P, b = bh >> 2;
    ci.h = bh & 3; ci.r0 = MPROMPT + 8 * b; ci.T = 8;
  }
  return ci;
}

constexpr int G_GKL = 0, G_BC = 4096, G_TOT = 20736, G_BL = 21760, G_QD = 22016, G_KI = 31232, G_ATT = 40448, G_RED = 49664;

DEVINL void gla_prep(const Params& p, char* smem, int r0, int T, int h, float (&bcum)[16]) {
  float* gkl = (float*)(smem + G_GKL); float* Bc = (float*)(smem + G_BC);
  float* tot = (float*)(smem + G_TOT); float* bl = (float*)(smem + G_BL);
  const int tid = tidx(), lane = tid & 63, w = tid >> 6;
  const float* gk = (const float*)(p.ws + OFF_GK);
  __syncthreads();
  {
    int t = tid >> 2, c4 = (tid & 3) * 4;
    const float4 v = *(const float4*)(gk + (size_t)(r0 + t) * 16 + c4);
    *(float4*)(gkl + t * 16 + c4) = v;
  }
  float wreg[16];
#pragma unroll
  for (int r = 0; r < 16; ++r) wreg[r] = p.w_gk2[r * 256 + h * 64 + lane];
  const float bias = p.b_gk[h * 64 + lane];
  __syncthreads();
  float run = 0.f;
#pragma unroll
  for (int i = 0; i < 16; ++i) {
    const int t = 16 * w + i;
    float z = bias;
#pragma unroll
    for (int r4 = 0; r4 < 4; ++r4) {
      float4 gv = *(const float4*)(gkl + t * 16 + r4 * 4);
      z += gv.x * wreg[r4 * 4] + gv.y * wreg[r4 * 4 + 1] + gv.z * wreg[r4 * 4 + 2] + gv.w * wreg[r4 * 4 + 3];
    }
    float lg = (t < T) ? logsigf_(z) * (1.f / 16.f) : 0.f;
    run += lg;
    bcum[i] = run;
  }
  tot[w * 64 + lane] = run;
  __syncthreads();
  float off = 0.f, total = 0.f;
#pragma unroll
  for (int w2 = 0; w2 < 4; ++w2) { float v = tot[w2 * 64 + lane]; if (w2 < w) off += v; total += v; }
#pragma unroll
  for (int i = 0; i < 16; ++i) { bcum[i] += off; Bc[(16 * w + i) * 65 + lane] = bcum[i]; }
  if (w == 0) bl[lane] = total;
  __syncthreads();
}

DEVINL void gla_passA(const Params& p, char* smem, int item) {
  const ChunkInfo ci = chunk_info(item);
  const int tid = tidx(), lane = tid & 63, w = tid >> 6;
  const u16* kT = (const u16*)(p.ws + OFF_KT); const u16* vT = (const u16*)(p.ws + OFF_VT);
  bf16x8 kr[2][4], vb[2][2];
#pragma unroll
  for (int ks = 0; ks < 2; ++ks) {
    const int tb = ks * 32 + 8 * (lane >> 4);
#pragma unroll
    for (int nf = 0; nf < 2; ++nf)
      vb[ks][nf] = *(const bf16x8*)(vT + (size_t)(ci.h * 128 + 32 * w + nf * 16 + (lane & 15)) * LDT + ci.r0 + tb);
#pragma unroll
    for (int mf = 0; mf < 4; ++mf)
      kr[ks][mf] = *(const bf16x8*)(kT + (size_t)(ci.h * 64 + mf * 16 + (lane & 15)) * LDT + ci.r0 + tb);
  }
  float bcum[16];
  gla_prep(p, smem, ci.r0, ci.T, ci.h, bcum);
  {
    float* bc = (float*)(p.ws + OFF_BCUM) + (size_t)item * 4096;
#pragma unroll
    for (int i = 0; i < 16; ++i) bc[(16 * w + i) * 64 + lane] = bcum[i];
  }
  const float* Bc = (const float*)(smem + G_BC); const float* bl = (const float*)(smem + G_BL);
  f32x4 acc[4][2];
#pragma unroll
  for (int a = 0; a < 4; ++a) { acc[a][0] = f32x4{0, 0, 0, 0}; acc[a][1] = f32x4{0, 0, 0, 0}; }
#pragma unroll
  for (int ks = 0; ks < 2; ++ks) {
    const int tb = ks * 32 + 8 * (lane >> 4);
    bf16x8 bfr[2];
#pragma unroll
    for (int nf = 0; nf < 2; ++nf) bfr[nf] = vb[ks][nf];
#pragma unroll
    for (int mf = 0; mf < 4; ++mf) {
      const int d = mf * 16 + (lane & 15);
      const bf16x8 kraw = kr[ks][mf];
      const float bld = bl[d];
      bf16x8 afr;
#pragma unroll
      for (int j = 0; j < 8; ++j) {
        int t = tb + j;
        float e = __expf(bld - Bc[t * 65 + d]);
        afr[j] = (t < ci.T) ? (short)f2bf(bf2f((u16)kraw[j]) * e) : (short)0;
      }
#pragma unroll
      for (int nf = 0; nf < 2; ++nf) acc[mf][nf] = mfma16(afr, bfr[nf], acc[mf][nf]);
    }
  }
  float* dS = (float*)(p.ws + OFF_DS) + (size_t)item * 8192;
#pragma unroll
  for (int mf = 0; mf < 4; ++mf)
#pragma unroll
    for (int nf = 0; nf < 2; ++nf)
#pragma unroll
      for (int j = 0; j < 4; ++j) {
        int d = mf * 16 + (lane >> 4) * 4 + j, dv = 32 * w + nf * 16 + (lane & 15);
        dS[d * 128 + dv] = acc[mf][nf][j];
      }
  if (w == 0) ((float*)(p.ws + OFF_DECAY))[(size_t)item * 64 + lane] = __expf(bl[lane]);
}

DEVINL void gla_passB(const Params& p, int idx) {
  const int chain = idx >> 2, dvg = idx & 3;
  const int tid = tidx(), dv = dvg * 32 + (tid & 31), d0 = (tid >> 5) * 8;
  float S[8];
  int item0, nchunks; float* outp;
  if (chain < 32) {
    item0 = chain * 33; nchunks = 33;
    outp = p.out + OUT_GP + (size_t)chain * 8192;
#pragma unroll
    for (int i = 0; i < 8; ++i) S[i] = 0.f;
  } else {
    int bh = chain - 32;
    item0 = NCH_P + bh; nchunks = 1;
    outp = p.out + OUT_GS + (size_t)bh * 8192;
#pragma unroll
    for (int i = 0; i < 8; ++i) S[i] = p.state_gla[(size_t)bh * 8192 + (d0 + i) * 128 + dv];
  }
  const float* dS = (const float*)(p.ws + OFF_DS); const float* decay = (const float*)(p.ws + OFF_DECAY);
  u16* SpT = (u16*)(p.ws + OFF_SPT);
  const float* dSb = dS + (size_t)item0 * 8192 + d0 * 128 + dv;
  const float* dcb = decay + (size_t)item0 * 64 + d0;
  u16* spb = SpT + (size_t)item0 * 8192 + dv * 64 + d0;
  int c = 0;
  for (; c + 4 <= nchunks; c += 4) {
    float v[4][8], dc[4][8];
#pragma unroll
    for (int q = 0; q < 4; ++q)
#pragma unroll
      for (int i = 0; i < 8; ++i) { v[q][i] = dSb[(size_t)(c + q) * 8192 + i * 128]; dc[q][i] = dcb[(c + q) * 64 + i]; }
#pragma unroll
    for (int q = 0; q < 4; ++q) {
      *(uint4*)(spb + (size_t)(c + q) * 8192) =
          make_uint4(pack2(S[0], S[1]), pack2(S[2], S[3]), pack2(S[4], S[5]), pack2(S[6], S[7]));
#pragma unroll
      for (int i = 0; i < 8; ++i) S[i] = dc[q][i] * S[i] + v[q][i];
    }
  }
  for (; c < nchunks; ++c) {
    float v[8], dc[8];
#pragma unroll
    for (int i = 0; i < 8; ++i) { v[i] = dSb[(size_t)c * 8192 + i * 128]; dc[i] = dcb[c * 64 + i]; }
    *(uint4*)(spb + (size_t)c * 8192) =
        make_uint4(pack2(S[0], S[1]), pack2(S[2], S[3]), pack2(S[4], S[5]), pack2(S[6], S[7]));
#pragma unroll
    for (int i = 0; i < 8; ++i) S[i] = dc[i] * S[i] + v[i];
  }
#pragma unroll
  for (int i = 0; i < 8; ++i) outp[(d0 + i) * 128 + dv] = S[i];
}

DEVINL void gla_passC(const Params& p, char* smem, int item) {
  const ChunkInfo ci = chunk_info(item);
  const int tid = tidx(), lane = tid & 63, w = tid >> 6;
  const u16* qk = (const u16*)(p.ws + OFF_QK);
  const u16* vT = (const u16*)(p.ws + OFF_VT);
  const u16* SpT = (const u16*)(p.ws + OFF_SPT) + (size_t)item * 8192;
  const u16* gbuf = (const u16*)(p.ws + OFF_GB);
  u16 qraw[16], kraw16[16];
#pragma unroll
  for (int i = 0; i < 16; ++i) {
    const int t = 16 * w + i;
    qraw[i] = qk[(size_t)(ci.r0 + t) * 512 + ci.h * 64 + lane];
    kraw16[i] = qk[(size_t)(ci.r0 + t) * 512 + 256 + ci.h * 64 + lane];
  }
  bf16x8 bvv[2][2], bss[2][2];
#pragma unroll
  for (int ks = 0; ks < 2; ++ks) {
    const int kb = ks * 32 + 8 * (lane >> 4);
#pragma unroll
    for (int nf = 0; nf < 2; ++nf) {
      const int dv = 32 * w + nf * 16 + (lane & 15);
      bvv[ks][nf] = *(const bf16x8*)(vT + (size_t)(ci.h * 128 + dv) * LDT + ci.r0 + kb);
      bss[ks][nf] = *(const bf16x8*)(SpT + dv * 64 + kb);
    }
  }
  u16 graw[4][2][4];
#pragma unroll
  for (int mf = 0; mf < 4; ++mf) {
    const int t0 = mf * 16 + (lane >> 4) * 4;
#pragma unroll
    for (int nf = 0; nf < 2; ++nf)
#pragma unroll
      for (int j = 0; j < 4; ++j)
        graw[mf][nf][j] = gbuf[(size_t)(ci.r0 + t0 + j) * 512 + ci.h * 128 + 32 * w + nf * 16 + (lane & 15)];
  }
  float bcum[16];
  {
    const float* bc = (const float*)(p.ws + OFF_BCUM) + (size_t)item * 4096;
#pragma unroll
    for (int i = 0; i < 16; ++i) bcum[i] = bc[(16 * w + i) * 64 + lane];
  }
  __syncthreads();
  u16* Qd = (u16*)(smem + G_QD); u16* Ki = (u16*)(smem + G_KI); u16* Att = (u16*)(smem + G_ATT);
  float* red = (float*)(smem + G_RED);
#pragma unroll
  for (int i = 0; i < 16; ++i) {
    const int t = 16 * w + i;
    const float qv = (t < ci.T) ? bf2f(qraw[i]) : 0.f, kv = (t < ci.T) ? bf2f(kraw16[i]) : 0.f;
    const float bt = bcum[i];
    Qd[t * 72 + lane] = f2bf(qv * __expf(bt));
    Ki[t * 72 + lane] = f2bf(kv * __expf(-bt));
  }
  __syncthreads();
  {
    f32x4 at[4];
#pragma unroll
    for (int nf = 0; nf < 4; ++nf) at[nf] = f32x4{0, 0, 0, 0};
#pragma unroll
    for (int ks = 0; ks < 2; ++ks) {
      bf16x8 a = *(const bf16x8*)(Qd + (16 * w + (lane & 15)) * 72 + ks * 32 + 8 * (lane >> 4));
#pragma unroll
      for (int nf = 0; nf < 4; ++nf) {
        bf16x8 b = *(const bf16x8*)(Ki + (nf * 16 + (lane & 15)) * 72 + ks * 32 + 8 * (lane >> 4));
        at[nf] = mfma16(a, b, at[nf]);
      }
    }
#pragma unroll
    for (int nf = 0; nf < 4; ++nf)
#pragma unroll
      for (int j = 0; j < 4; ++j) {
        int t = 16 * w + (lane >> 4) * 4 + j, s = nf * 16 + (lane & 15);
        Att[t * 72 + s] = f2bf((s <= t) ? at[nf][j] : 0.f);
      }
  }
  __syncthreads();
  f32x4 o[4][2];
#pragma unroll
  for (int a = 0; a < 4; ++a) { o[a][0] = f32x4{0, 0, 0, 0}; o[a][1] = f32x4{0, 0, 0, 0}; }
#pragma unroll
  for (int ks = 0; ks < 2; ++ks) {
    const int kb = ks * 32 + 8 * (lane >> 4);
    bf16x8 bv[2], bs[2];
#pragma unroll
    for (int nf = 0; nf < 2; ++nf) { bv[nf] = bvv[ks][nf]; bs[nf] = bss[ks][nf]; }
#pragma unroll
    for (int mf = 0; mf < 4; ++mf) {
      bf16x8 aa = *(const bf16x8*)(Att + (mf * 16 + (lane & 15)) * 72 + kb);
      bf16x8 aq = *(const bf16x8*)(Qd + (mf * 16 + (lane & 15)) * 72 + kb);
#pragma unroll
      for (int nf = 0; nf < 2; ++nf) {
        o[mf][nf] = mfma16(aa, bv[nf], o[mf][nf]);
        o[mf][nf] = mfma16(aq, bs[nf], o[mf][nf]);
      }
    }
  }
#pragma unroll
  for (int mf = 0; mf < 4; ++mf)
#pragma unroll
    for (int j = 0; j < 4; ++j) {
      const float s = red16(o[mf][0][j] * o[mf][0][j] + o[mf][1][j] * o[mf][1][j]);
      red[w * 64 + mf * 16 + (lane >> 4) * 4 + j] = s;
    }
  __syncthreads();
  u16* mixin = (u16*)(p.ws + OFF_MIXIN);
  float gn[2];
#pragma unroll
  for (int nf = 0; nf < 2; ++nf) gn[nf] = p.gla_norm[32 * w + nf * 16 + (lane & 15)];
#pragma unroll
  for (int mf = 0; mf < 4; ++mf) {
    const int t0 = mf * 16 + (lane >> 4) * 4;
    if (t0 < ci.T) {
      float rs[4];
#pragma unroll
      for (int j = 0; j < 4; ++j) {
        const int t = t0 + j;
        rs[j] = rsqrtf((red[t] + red[64 + t] + red[128 + t] + red[192 + t]) * (1.f / 128.f) + EPS);
      }
#pragma unroll
      for (int nf = 0; nf < 2; ++nf) {
        const int dv = 32 * w + nf * 16 + (lane & 15);
        float o4[4];
#pragma unroll
        for (int j = 0; j < 4; ++j) {
          float gv = bf2f(graw[mf][nf][j]);
          o4[j] = o[mf][nf][j] * rs[j] * gn[nf] * siluf_(gv);
        }
        store_pairs(mixin, 1024, ci.r0 + t0, ci.h * 128 + dv, o4[0], o4[1], o4[2], o4[3]);
      }
    }
  }
}

DEVINL void s5_seg(const Params& p, char* wsm, int rb, int ntok, int g, float& hr, float& hi, bool outp) {
  const int lane = tidx() & 63;
  float* BUs = (float*)wsm;
  u16* Hs = (u16*)(wsm + 8448);
  const float2 ab = ((const float2*)(p.ws + OFF_ABAR))[g * 64 + lane];
  const u16* bbt = (const u16*)(p.ws + OFF_BBT); const u16* ct = (const u16*)(p.ws + OFF_CT);
  const u16* ub = (const u16*)(p.ws + OFF_UB); u16* yg = (u16*)(p.ws + OFF_YG);
  const bf16x8 zero8 = {0, 0, 0, 0, 0, 0, 0, 0};
  bf16x8 bb[8];
#pragma unroll
  for (int nf = 0; nf < 8; ++nf)
    bb[nf] = ((lane >> 4) < 2) ? *(const bf16x8*)(bbt + ((size_t)g * 128 + nf * 16 + (lane & 15)) * 16 + 8 * (lane >> 4)) : zero8;
  bf16x8 cm[4];
#pragma unroll
  for (int ks = 0; ks < 4; ++ks)
    cm[ks] = *(const bf16x8*)(ct + ((size_t)g * 16 + (lane & 15)) * 128 + ks * 32 + 8 * (lane >> 4));
  const float dsk = p.s5_d[g * 16 + (lane & 15)];
  const int tk0 = (lane >> 4) * 4, ucol = g * 16 + (lane & 15);
  bf16x8 a_nxt = zero8;
  u16 u_nxt[4] = {0, 0, 0, 0};
  {
    const int nt0 = min(16, ntok);
    if ((lane >> 4) < 2 && (lane & 15) < nt0)
      a_nxt = *(const bf16x8*)(ub + (size_t)(rb + (lane & 15)) * 512 + g * 16 + 8 * (lane >> 4));
    if (outp && tk0 < nt0) {
#pragma unroll
      for (int j = 0; j < 4; ++j) u_nxt[j] = ub[(size_t)(rb + tk0 + j) * 512 + ucol];
    }
  }
  for (int t0 = 0; t0 < ntok; t0 += 16) {
    const int nt = min(16, ntok - t0);
    const bf16x8 a = a_nxt;
    u16 u_cur[4];
#pragma unroll
    for (int j = 0; j < 4; ++j) u_cur[j] = u_nxt[j];
    if (t0 + 16 < ntok) {
      const int ntn = min(16, ntok - t0 - 16);
      a_nxt = zero8;
      if ((lane >> 4) < 2 && (lane & 15) < ntn)
        a_nxt = *(const bf16x8*)(ub + (size_t)(rb + t0 + 16 + (lane & 15)) * 512 + g * 16 + 8 * (lane >> 4));
      if (outp && tk0 < ntn) {
#pragma unroll
        for (int j = 0; j < 4; ++j) u_nxt[j] = ub[(size_t)(rb + t0 + 16 + tk0 + j) * 512 + ucol];
      }
    }
#pragma unroll
    for (int nf = 0; nf < 8; ++nf) {
      f32x4 c = mfma16(a, bb[nf], f32x4{0, 0, 0, 0});
#pragma unroll
      for (int j = 0; j < 4; ++j) BUs[((lane >> 4) * 4 + j) * 132 + nf * 16 + (lane & 15)] = c[j];
    }
    __builtin_amdgcn_wave_barrier();
    asm volatile("s_waitcnt lgkmcnt(0)" ::: "memory");
    if (nt == 16) {
      float2 bu[16];
#pragma unroll
      for (int t = 0; t < 16; ++t) bu[t] = *(const float2*)(BUs + t * 132 + 2 * lane);
#pragma unroll
      for (int t = 0; t < 16; ++t) {
        float nr = ab.x * hr - ab.y * hi + bu[t].x;
        float ni = ab.x * hi + ab.y * hr + bu[t].y;
        hr = nr; hi = ni;
        if (outp) *(unsigned*)(Hs + t * 136 + 2 * lane) = pack2(hr, hi);
      }
    } else {
      for (int t = 0; t < nt; ++t) {
        float2 bu = *(const float2*)(BUs + t * 132 + 2 * lane);
        float nr = ab.x * hr - ab.y * hi + bu.x;
        float ni = ab.x * hi + ab.y * hr + bu.y;
        hr = nr; hi = ni;
        if (outp) *(unsigned*)(Hs + t * 136 + 2 * lane) = pack2(hr, hi);
      }
    }
    __builtin_amdgcn_wave_barrier();
    asm volatile("s_waitcnt lgkmcnt(0)" ::: "memory");
    if (outp) {
      f32x4 y = f32x4{0, 0, 0, 0};
#pragma unroll
      for (int ks = 0; ks < 4; ++ks) {
        bf16x8 ha = *(const bf16x8*)(Hs + (lane & 15) * 136 + ks * 32 + 8 * (lane >> 4));
        y = mfma16(ha, cm[ks], y);
      }
      if (tk0 < nt) {
        float yv[4];
#pragma unroll
        for (int j = 0; j < 4; ++j) yv[j] = geluf_(y[j] + dsk * bf2f(u_cur[j]));
        store_pairs(yg, 512, rb + t0 + tk0, ucol, yv[0], yv[1], yv[2], yv[3]);
      }
      __builtin_amdgcn_wave_barrier();
      asm volatile("s_waitcnt lgkmcnt(0)" ::: "memory");
    }
  }
}

DEVINL void seg_rows(int b, int s, int& rb, int& ntok) {
  if (s == 0) { rb = b * LP; ntok = 272; } else { rb = b * LP + 272 + 256 * (s - 1); ntok = 256; }
}

DEVINL void s5_passA(const Params& p, char* smem, int item) {
  const int lane = tidx() & 63, wid = tidx() >> 6;
  const int bq = item / 7, s = item - bq * 7, b = bq >> 3, g = (bq & 7) * 4 + wid;
  const int bg = b * 32 + g;
  int rb, ntok; seg_rows(b, s, rb, ntok);
  float hr = 0.f, hi = 0.f;
  s5_seg(p, smem + wid * 12800, rb, ntok, g, hr, hi, false);
  ((float2*)(p.ws + OFF_HEND))[((size_t)bg * 7 + s) * 64 + lane] = make_float2(hr, hi);
}

DEVINL void s5_passC_prompt(const Params& p, char* smem, int item) {
  const int lane = tidx() & 63, wid = tidx() >> 6;
  const int bq = item >> 3, s = item & 7, b = bq >> 3, g = (bq & 7) * 4 + wid;
  const int bg = b * 32 + g;
  int rb, ntok; seg_rows(b, s, rb, ntok);
  float hr = 0.f, hi = 0.f;
  const float4 pw = ((const float4*)(p.ws + OFF_APW))[g * 64 + lane];
  const float2* hend = (const float2*)(p.ws + OFF_HEND);
  for (int s2 = 0; s2 < s; ++s2) {
    float pr = (s2 == 0) ? pw.z : pw.x, pi = (s2 == 0) ? pw.w : pw.y;
    float2 he = hend[((size_t)bg * 7 + s2) * 64 + lane];
    float nr = pr * hr - pi * hi + he.x, ni = pr * hi + pi * hr + he.y;
    hr = nr; hi = ni;
  }
  s5_seg(p, smem + wid * 12800, rb, ntok, g, hr, hi, true);
  if (s == 7) {
    p.out[OUT_RP + (size_t)bg * 64 + lane] = hr;
    p.out[OUT_IP + (size_t)bg * 64 + lane] = hi;
  }
}

DEVINL void s5_passC_sample(const Params& p, char* smem, int item) {
  const int lane = tidx() & 63, wid = tidx() >> 6;
  const int b = item >> 3, g = (item & 7) * 4 + wid;
  const int wi = b * 32 + g;
  float hr = p.s5r0[(size_t)wi * 64 + lane], hi = p.s5i0[(size_t)wi * 64 + lane];
  s5_seg(p, smem + wid * 12800, MPROMPT + 8 * b, 8, g, hr, hi, true);
  p.out[OUT_RS + (size_t)wi * 64 + lane] = hr;
  p.out[OUT_IS + (size_t)wi * 64 + lane] = hi;
}

DEVINL float wave_sum(float v) {
  v = red16(v);
  v += __shfl_xor(v, 16);
  v += __shfl_xor(v, 32);
  return v;
}
DEVINL void unpack4(uint2 q, float (&f)[4]) {
  f[0] = bf2f((u16)(q.x & 0xffff)); f[1] = bf2f((u16)(q.x >> 16));
  f[2] = bf2f((u16)(q.y & 0xffff)); f[3] = bf2f((u16)(q.y >> 16));
}
template <int R>
DEVINL void p5_rows(const Params& p, int r0) {
  const int lane = tidx() & 63;
  float4 xv[R][4]; uint2 mq[R][4];
#pragma unroll
  for (int q = 0; q < R; ++q) {
    const float* x = xrow_ptr(p, r0 + q);
    const u16* mo = (const u16*)(p.ws + OFF_MIXO) + (size_t)(r0 + q) * DM;
#pragma unroll
    for (int i = 0; i < 4; ++i) { xv[q][i] = *(const float4*)(x + i * 256 + lane * 4); mq[q][i] = *(const uint2*)(mo + i * 256 + lane * 4); }
  }
  float4 g[4];
#pragma unroll
  for (int i = 0; i < 4; ++i) g[i] = *(const float4*)(p.g_post_mix + i * 256 + lane * 4);
#pragma unroll
  for (int q = 0; q < R; ++q) {
    float m[4][4];
    float ssm = 0.f;
#pragma unroll
    for (int i = 0; i < 4; ++i) {
      unpack4(mq[q][i], m[i]);
      ssm += m[i][0] * m[i][0] + m[i][1] * m[i][1] + m[i][2] * m[i][2] + m[i][3] * m[i][3];
    }
    const float rsm = rsqrtf(wave_sum(ssm) * (1.f / DM) + EPS);
    u16* x1b = (u16*)(p.ws + OFF_X1B) + (size_t)(r0 + q) * DM;
    float ss = 0.f;
#pragma unroll
    for (int i = 0; i < 4; ++i) {
      const float4 v = xv[q][i];
      float a0 = v.x + m[i][0] * rsm * g[i].x, a1 = v.y + m[i][1] * rsm * g[i].y;
      float a2 = v.z + m[i][2] * rsm * g[i].z, a3 = v.w + m[i][3] * rsm * g[i].w;
      ss += a0 * a0 + a1 * a1 + a2 * a2 + a3 * a3;
      *(uint2*)(x1b + i * 256 + lane * 4) = make_uint2(pack2(a0, a1), pack2(a2, a3));
    }
    ss = wave_sum(ss);
    if (lane == 0) {
      ((float*)(p.ws + OFF_RSTD1X))[ridx(r0 + q)] = rsqrtf(ss * (1.f / DM) + EPS);
    }
  }
}

template <int R>
DEVINL void p8_rows(const Params& p, int r0) {
  const int lane = tidx() & 63;
  uint2 xq[R][4], fq0[R][4], fq1[R][4];
  float* op[R];
#pragma unroll
  for (int q = 0; q < R; ++q) {
    op[q] = outrow_ptr(p, r0 + q);
    const u16* x1 = (const u16*)(p.ws + OFF_X1B) + (size_t)(r0 + q) * DM;
    const u16* f0 = (const u16*)(p.ws + OFF_FB) + (size_t)(r0 + q) * DM;
    const u16* f1 = (const u16*)(p.ws + OFF_FB1) + (size_t)(r0 + q) * DM;
#pragma unroll
    for (int i = 0; i < 4; ++i) {
      const int c = i * 256 + lane * 4;
      xq[q][i] = *(const uint2*)(x1 + c);
      fq0[q][i] = *(const uint2*)(f0 + c); fq1[q][i] = *(const uint2*)(f1 + c);
    }
  }
  float4 g2[4];
#pragma unroll
  for (int i = 0; i < 4; ++i) g2[i] = *(const float4*)(p.g_post_ffn + i * 256 + lane * 4);
#pragma unroll
  for (int q = 0; q < R; ++q) {
    if (!op[q]) continue;
    float f[4][4];
    float ssf = 0.f;
#pragma unroll
    for (int i = 0; i < 4; ++i) {
      float f1[4];
      unpack4(fq0[q][i], f[i]); unpack4(fq1[q][i], f1);
      f[i][0] += f1[0]; f[i][1] += f1[1]; f[i][2] += f1[2]; f[i][3] += f1[3];
      ssf += f[i][0] * f[i][0] + f[i][1] * f[i][1] + f[i][2] * f[i][2] + f[i][3] * f[i][3];
    }
    const float rsf = rsqrtf(wave_sum(ssf) * (1.f / DM) + EPS);
#pragma unroll
    for (int i = 0; i < 4; ++i) {
      float x1v[4];
      unpack4(xq[q][i], x1v);
      float4 r4;
      r4.x = x1v[0] + f[i][0] * rsf * g2[i].x;
      r4.y = x1v[1] + f[i][1] * rsf * g2[i].y;
      r4.z = x1v[2] + f[i][2] * rsf * g2[i].z;
      r4.w = x1v[3] + f[i][3] * rsf * g2[i].w;
      *(float4*)(op[q] + i * 256 + lane * 4) = r4;
    }
  }
}

#define XB_TMO      128
#define XB_XCNT(j)  (256  + 64 * (j))
#define XB_XSUB(j)  (1280 + 64 * (j))
#define XB_XGEN(j)  (2304 + 64 * (j))
#define XB_TOP      3328
#define XB_TOPGEN   3392
#define XCD_BAR_WORDS 3456
#define XB_SPIN_CAP (1u << 18)
DEVINL unsigned xb_ld(unsigned* p) { return __hip_atomic_load(p, __ATOMIC_RELAXED, __HIP_MEMORY_SCOPE_AGENT); }
DEVINL unsigned xb_add(unsigned* p, unsigned v) { return __hip_atomic_fetch_add(p, v, __ATOMIC_RELAXED, __HIP_MEMORY_SCOPE_AGENT); }
DEVINL unsigned xb_xcc_id() { return (unsigned)__builtin_amdgcn_s_getreg((3 << 11) | 20) & 0xFu; }
#define XB_SPIN(cond, bar) do { unsigned _sp = 0; while (cond) { __builtin_amdgcn_s_sleep(1); \
    if ((++_sp & 255u) == 0u) { if (xb_ld(&(bar)[XB_TMO])) break; if (_sp > XB_SPIN_CAP) { atomicAdd(&(bar)[XB_TMO], 1u); break; } } } } while (0)
struct XcdBarrier { unsigned* bar; unsigned x; unsigned nloc, nx; };
DEVINL XcdBarrier xcd_barrier_post(unsigned* bar) {
  XcdBarrier b; b.bar = bar; b.x = xb_xcc_id(); b.nloc = 0u; b.nx = 0u;
  if (tidx() == 0) (void)xb_add(&bar[XB_XCNT(b.x)], 1u);
  return b;
}
DEVINL void xcd_barrier_complete(unsigned* bar, unsigned x, unsigned& nloc, unsigned& nx) {
  const unsigned G = gridDim.x;
  unsigned sum, cnt, mine, sp = 0u;
  for (;;) {
    sum = 0u; cnt = 0u; mine = 0u;
#pragma unroll
    for (unsigned j = 0; j < 16; ++j) { const unsigned c = xb_ld(&bar[XB_XCNT(j)]); sum += c; cnt += (c > 0u) ? 1u : 0u; mine = (j == x) ? c : mine; }
    if (sum == G) break;
    __builtin_amdgcn_s_sleep(1);
    if ((++sp & 255u) == 0u) { if (xb_ld(&bar[XB_TMO])) break; if (sp > XB_SPIN_CAP) { atomicAdd(&bar[XB_TMO], 1u); break; } }
  }
  nloc = mine > 0u ? mine : 1u; nx = cnt > 0u ? cnt : 1u;
}
DEVINL void xcd_barrier(XcdBarrier& b) {
  asm volatile("s_waitcnt vmcnt(0)" ::: "memory");
  __syncthreads();
  if (tidx() == 0) {
    unsigned* bar = b.bar;
    __builtin_amdgcn_s_waitcnt(0);
    if (b.nloc == 0u) xcd_barrier_complete(bar, b.x, b.nloc, b.nx);
    const unsigned nloc = b.nloc, nx = b.nx;
    const unsigned old = xb_add(&bar[XB_XSUB(b.x)], 1u);
    const unsigned gen = old / nloc;
    if (old + 1u == (gen + 1u) * nloc) {
      __builtin_amdgcn_fence(__ATOMIC_RELEASE, "agent");
      asm volatile("s_waitcnt vmcnt(0)" ::: "memory");
      const unsigned og = xb_add(&bar[XB_TOP], 1u);
      const unsigned tg = og / nx;
      if (og + 1u == (tg + 1u) * nx) xb_add(&bar[XB_TOPGEN], 1u);
      else XB_SPIN(xb_ld(&bar[XB_TOPGEN]) == tg, bar);
      __builtin_amdgcn_fence(__ATOMIC_ACQUIRE, "agent");
      xb_add(&bar[XB_XGEN(b.x)], 1u);
      asm volatile("s_waitcnt vmcnt(0)" ::: "memory");
    } else {
      XB_SPIN(xb_ld(&bar[XB_XGEN(b.x)]) == gen, bar);
      __builtin_amdgcn_fence(__ATOMIC_ACQUIRE, "agent");
      asm volatile("s_waitcnt vmcnt(0)" ::: "memory");
    }
  }
  __syncthreads();
}

constexpr int NPHASE = 11;
constexpr int S5A_BLK = 1792 / 4;
constexpr int S5CP_BLK = 2048 / 4;
constexpr int S5CS_BLK = 4096 / 4;
constexpr int GLAB_ITEMS = 544 * 4;

DEVINL int light_index(int NT, int& nlight) {
  const int bid = bidx(), nb = gridDim.x;
  const int U = MT * NT;
  nlight = nb;
  if ((nb & 7) != 0) return bid;
  const int nbx = nb >> 3, x = bid & 7, j = bid >> 3;
  int total = 0, mine = -1;
  for (int c = 0; c < 8; ++c) {
    const int n = (int)(((long)U * (c + 1)) >> 3) - (int)(((long)U * c) >> 3);
    const int r = n % nbx;
    const int nl = (r == 0) ? nbx : nbx - r;
    if (c == x) mine = (r == 0) ? total + j : ((j >= r) ? total + (j - r) : -1);
    total += nl;
  }
  nlight = total;
  return mine;
}

template <class F>
DEVINL void gemm_phase(int NT, F&& f) {
  const int bid = bidx(), nb = gridDim.x;
  const int U = MT * NT;
  if ((nb & 7) != 0) {
    bool first = true;
    for (int t = bid; t < U; t += nb) {
      const int tn = t + nb; const bool hn = tn < U;
      f(t / NT, t % NT, first, hn, hn ? tn / NT : 0, hn ? tn % NT : 0);
      first = false;
    }
    return;
  }
  const int x = bid & 7, j = bid >> 3, nbx = nb >> 3;
  const int u0 = (int)(((long)U * x) >> 3), u1 = (int)(((long)U * (x + 1)) >> 3);
  auto decode = [&](int u, int& mt, int& nt) {
    const int band = u / (8 * MT), v = u - band * 8 * MT;
    const int w = min(8, NT - band * 8);
    mt = v / w; nt = band * 8 + v % w;
  };
  bool first = true;
  for (int u = u0 + j; u < u1; u += nbx) {
    int mt, nt, mtn = 0, ntn = 0;
    decode(u, mt, nt);
    const bool hn = (u + nbx) < u1;
    if (hn) decode(u + nbx, mtn, ntn);
    f(mt, nt, first, hn, mtn, ntn);
    first = false;
  }
}

DEVINL void run_phase(const Params& p, char* smem, int ph) {
  const int bid = bidx(), nb = gridDim.x;
  switch (ph) {
    case 0: phase0(p, smem); break;
    case 1:
      gemm_phase(17, [&](int mt, int nt, bool fi, bool hn, int mtn, int ntn) { p1_tile(p, smem, mt, nt, fi, hn, mtn, ntn); });
      break;
    case 2:
      for (int it = bid; it < NCH + S5A_BLK; it += nb) {
        if (it < S5A_BLK) { __syncthreads(); s5_passA(p, smem, it); }
        else gla_passA(p, smem, it - S5A_BLK);
      }
      break;
    case 3:
      for (int it = bid; it < S5CP_BLK + GLAB_ITEMS + S5CS_BLK; it += nb) {
        if (it < S5CP_BLK) { __syncthreads(); s5_passC_prompt(p, smem, it); }
        else if (it < S5CP_BLK + GLAB_ITEMS) gla_passB(p, it - S5CP_BLK);
        else { __syncthreads(); s5_passC_sample(p, smem, it - S5CP_BLK - GLAB_ITEMS); }
      }
      break;
    case 4:
      gemm_phase(4, [&](int mt, int nt, bool fi, bool hn, int mtn, int ntn) { p3_tile(p, smem, mt, nt, fi, hn, mtn, ntn); });
      for (int it = nb - 1 - bid; it < NCH; it += nb) gla_passC(p, smem, it);
      break;
    case 5:
      break;
    case 6:
      gemm_phase(8, [&](int mt, int nt, bool fi, bool hn, int mtn, int ntn) { p4_tile(p, smem, mt, nt, fi, hn, mtn, ntn); });
      {
        int nlight;
        const int li = light_index(8, nlight);
        if (li >= 0)
          for (int t = li; t < TR3 + TR4; t += nlight) ffn_weight_tile(p, smem, t);
      }
      break;
    case 7:
      for (int it = bid; it < M / 16; it += nb)
        for (int i = 0; i < 4; i += 2) p5_rows<2>(p, it * 16 + (tidx() >> 6) * 4 + i);
      break;
    case 8:
      gemm_phase(44, [&](int mt, int nt, bool fi, bool hn, int mtn, int ntn) { p6_tile(p, smem, mt, nt, fi, hn, mtn, ntn); });
      break;
    case 9:
      gemm_phase(16, [&](int mt, int nt, bool fi, bool hn, int mtn, int ntn) { p7_tile(p, smem, mt, nt, fi, hn, mtn, ntn); });
      break;
    case 10:
      for (int it = bid; it < M / 8; it += nb) p8_rows<2>(p, it * 8 + (tidx() >> 6) * 2);
      break;
  }
}

#if SINGLE_LAUNCH
__global__ void __launch_bounds__(256, 2) mega_kernel(Params p) {
  __shared__ __attribute__((aligned(16))) char smem[65536];
  XcdBarrier xb = xcd_barrier_post((unsigned*)(p.ws + OFF_BAR));
  if (tidx() == 0) { __builtin_amdgcn_fence(__ATOMIC_RELEASE, ""); asm volatile("s_waitcnt vmcnt(0)" ::: "memory"); }
  xcd_barrier(xb);
#pragma unroll 1
  for (int ph = 0; ph < NPHASE; ++ph) {
    if (ph == 5) continue;
    run_phase(p, smem, ph);
    if (ph + 1 < NPHASE) xcd_barrier(xb);
  }
}
#else

__global__ void __launch_bounds__(256, 2) phase_kernel(Params p, int ph) {
  __shared__ __attribute__((aligned(16))) char smem[65536];
  run_phase(p, smem, ph);
}
#endif

extern "C" void kernel_launch(void* const* d_in, const int* in_sizes, int n_in, void* d_out, int out_size,
                              void* d_ws, size_t ws_size, hipStream_t stream) {
  Params p{};
  const float** f = (const float**)&p;
  for (int i = 0; i < 28; ++i) f[i] = (const float*)d_in[i];
  p.out = (float*)d_out;
  p.ws = (char*)d_ws;
#if SINGLE_LAUNCH
  static int grid_blocks = 0;
  if (!grid_blocks) {
    int dev = 0, cus = 0, per_cu = 0;
    hipGetDevice(&dev);
    hipDeviceGetAttribute(&cus, hipDeviceAttributeMultiprocessorCount, dev);
    hipOccupancyMaxActiveBlocksPerMultiprocessor(&per_cu, mega_kernel, 256, 0);
    if (per_cu > 2) per_cu = 2;
    grid_blocks = cus * per_cu;
  }
  hipMemsetAsync((char*)d_ws + OFF_BAR, 0, XCD_BAR_WORDS * 4, stream);
  void* args[] = {&p};
  hipError_t e = hipLaunchCooperativeKernel((void*)mega_kernel, dim3(grid_blocks), dim3(256), args, 0, stream);
  if (e != hipSuccess) fprintf(stderr, "cooperative launch failed: %s (grid %d)\n", hipGetErrorString(e), grid_blocks);
#else
  for (int ph = 0; ph < NPHASE; ++ph) phase_kernel<<<512, 256, 0, stream>>>(p, ph);
#endif
}
```

```cpp
#include <hip/hip_runtime.h>
#include <hip/hip_bf16.h>
#include <hip/hip_cooperative_groups.h>
#include <cstdio>
namespace cg = cooperative_groups;

#ifndef SINGLE_LAUNCH
#define SINGLE_LAUNCH 1
#endif

#define DEVINL __device__ __forceinline__
typedef unsigned short u16;
using bf16x8 = __attribute__((ext_vector_type(8))) short;
using f32x4 = __attribute__((ext_vector_type(4))) float;

constexpr int DM = 1024;
constexpr int NB = 8, SEQ = 2048, NMETA = 16, LP = SEQ + NMETA;
constexpr int MPROMPT = NB * LP;
constexpr int SB = 128, SS = 8, MSAMPLE = SB * SS;
constexpr int M = MPROMPT + MSAMPLE;
constexpr int MT = M / 128;
constexpr int DIN = 2064;
constexpr int N1 = 2176;
constexpr int DFF = 2816;
constexpr int LDT = M + 64;
constexpr int NCH_P = NB * 4 * 33;
constexpr int NCH = NCH_P + SB * 4;
constexpr float EPS = 1e-6f;

constexpr size_t al256(size_t x) { return (x + 255) & ~(size_t)255; }
constexpr size_t OFF_W1T = 0;
constexpr size_t OFF_WGLUT = OFF_W1T + al256((size_t)N1 * 1024 * 2);
constexpr size_t OFF_WOT = OFF_WGLUT + al256((size_t)512 * 512 * 2);
constexpr size_t OFF_WGUT = OFF_WOT + al256((size_t)1024 * 1024 * 2);
constexpr size_t OFF_WDT = OFF_WGUT + al256((size_t)5632 * 1024 * 2);
constexpr size_t OFF_SMALL = OFF_WDT + al256((size_t)1024 * DFF * 2);
constexpr size_t OFF_RSTD0 = OFF_SMALL;
constexpr size_t OFF_SS5 = OFF_RSTD0 + al256((size_t)M * 4);
constexpr size_t OFF_SSMIX = OFF_SS5 + al256((size_t)M * 4);
constexpr size_t OFF_SSF = OFF_SSMIX + al256((size_t)M * 4);
constexpr size_t OFF_RSTD1 = OFF_SSF + al256((size_t)M * 4);
constexpr size_t OFF_DECAY = OFF_RSTD1 + al256((size_t)M * 4);
constexpr size_t OFF_HEND = OFF_DECAY + al256((size_t)NCH * 64 * 4);
constexpr size_t OFF_ABAR = OFF_HEND + al256((size_t)256 * 7 * 64 * 2 * 4);
constexpr size_t OFF_APW = OFF_ABAR + al256((size_t)32 * 64 * 2 * 4);
constexpr size_t OFF_BBT = OFF_APW + al256((size_t)32 * 64 * 4 * 4);
constexpr size_t OFF_CT = OFF_BBT + al256((size_t)32 * 128 * 16 * 2);
constexpr size_t OFF_GK = OFF_CT + al256((size_t)32 * 16 * 128 * 2);
constexpr size_t OFF_BAR = OFF_GK + al256((size_t)M * 16 * 4);
constexpr size_t OFF_SS5P = OFF_BAR + al256((size_t)3456 * 4);
constexpr size_t OFF_RA = OFF_SS5P + al256((size_t)4 * M * 2 * 4);
constexpr size_t SZ_RA = al256((size_t)NCH * 8192 * 4);
constexpr size_t OFF_DS = OFF_RA, OFF_MIXO = OFF_RA;
constexpr size_t OFF_RB = OFF_RA + SZ_RA;
constexpr size_t OFF_QK = OFF_RB;
constexpr size_t OFF_KT = OFF_QK + al256((size_t)M * 512 * 2);
constexpr size_t OFF_VT = OFF_KT + al256((size_t)256 * LDT * 2);
constexpr size_t OFF_GB = OFF_VT + al256((size_t)512 * LDT * 2);
constexpr size_t OFF_UB = OFF_GB + al256((size_t)M * 512 * 2);
constexpr size_t OFF_RC = OFF_UB + al256((size_t)M * 512 * 2);
constexpr size_t OFF_X1B = OFF_RB;
constexpr size_t OFF_FB = OFF_RA;
constexpr size_t OFF_ACTB = OFF_RB + al256((size_t)M * 1024 * 2);
constexpr size_t OFF_SPT = OFF_RC;
constexpr size_t OFF_MIXIN = OFF_SPT + al256((size_t)NCH * 8192 * 2);
constexpr size_t OFF_YG = OFF_MIXIN + al256((size_t)M * 1024 * 2);
constexpr size_t OFF_XB = OFF_MIXIN;
constexpr size_t OFF_BCUM = al256(OFF_MIXIN + al256((size_t)M * 1024 * 2) + (size_t)M * 512 * 2);
static_assert(OFF_BCUM + (size_t)NCH * 4096 * 4 <= (size_t)268435456, "bcum fits the workspace tail");
constexpr size_t OFF_FB1 = al256(OFF_ACTB + (size_t)M * DFF * 2);
constexpr size_t WS_TOTAL = OFF_FB1 + al256((size_t)M * 1024 * 2);
static_assert(OFF_YG + al256((size_t)M * 512 * 2) <= WS_TOTAL, "yg fits");
static_assert(WS_TOTAL <= (size_t)268435456, "workspace too large");
static_assert((size_t)M * 1024 * 2 <= SZ_RA, "xb/mixo fit");

constexpr size_t OUT_YP = 0;
constexpr size_t OUT_YS = OUT_YP + (size_t)NB * SEQ * DM;
constexpr size_t OUT_GP = OUT_YS + (size_t)SB * SS * DM;
constexpr size_t OUT_RP = OUT_GP + (size_t)NB * 4 * 64 * 128;
constexpr size_t OUT_IP = OUT_RP + (size_t)NB * 32 * 64;
constexpr size_t OUT_GS = OUT_IP + (size_t)NB * 32 * 64;
constexpr size_t OUT_RS = OUT_GS + (size_t)SB * 4 * 64 * 128;
constexpr size_t OUT_IS = OUT_RS + (size_t)SB * 32 * 64;

struct Params {
  const float *x_prompt, *x_sample, *state_gla, *s5r0, *s5i0, *meta, *g_pre_mix, *w_in, *w_gk2, *b_gk, *gla_norm;
  const float *a_re, *a_im, *b_re, *b_im, *c_re, *c_im, *s5_d, *log_dt, *w_glu, *s5_norm, *w_o, *g_post_mix;
  const float *g_pre_ffn, *w_gate, *w_up, *w_down, *g_post_ffn;
  float* out;
  char* ws;
};

DEVINL int tidx() { int t = threadIdx.x; asm volatile("" : "+v"(t)); return t; }
DEVINL int bidx() { int t = blockIdx.x; asm volatile("" : "+s"(t)); return t; }
DEVINL u16 f2bf(float f) { return (u16)((__float_as_uint(f) + 0x8000u) >> 16); }
DEVINL float bf2f(u16 h) { return __uint_as_float(((unsigned)h) << 16); }
DEVINL unsigned pack2(float a, float b) {
  return __builtin_amdgcn_perm(__float_as_uint(b) + 0x8000u, __float_as_uint(a) + 0x8000u, 0x07060302u);
}
template <int CTRL> DEVINL float dpp_f(float v) {
  return __builtin_bit_cast(float, __builtin_amdgcn_update_dpp(0, __builtin_bit_cast(int, v), CTRL, 0xF, 0xF, true));
}
DEVINL float lane_xor1(float v) { return dpp_f<0xB1>(v); }
DEVINL float red16(float v) {
  v += dpp_f<0xB1>(v);
  v += dpp_f<0x4E>(v);
  v += dpp_f<0x141>(v);
  v += dpp_f<0x140>(v);
  return v;
}
DEVINL void store_pairs(u16* base, size_t ld, int rb, int col, float v0, float v1, float v2, float v3) {
  const float p0 = lane_xor1(v0), p1 = lane_xor1(v1), p2 = lane_xor1(v2), p3 = lane_xor1(v3);
  const bool odd = (col & 1) != 0;
  const int r0 = odd ? rb + 2 : rb, c0 = col & ~1;
  const unsigned w0 = odd ? pack2(p2, v2) : pack2(v0, p0);
  const unsigned w1 = odd ? pack2(p3, v3) : pack2(v1, p1);
  *(unsigned*)(base + (size_t)r0 * ld + c0) = w0;
  *(unsigned*)(base + (size_t)(r0 + 1) * ld + c0) = w1;
}
DEVINL float sigmoidf_(float x) { return __builtin_amdgcn_rcpf(1.f + __expf(-x)); }
DEVINL float siluf_(float x) { return x * __builtin_amdgcn_rcpf(1.f + __expf(-x)); }
DEVINL float geluf_(float x) {
  float u = 0.7978845608028654f * (x + 0.044715f * x * x * x);
  float t = 1.f - 2.f * __builtin_amdgcn_rcpf(__expf(2.f * u) + 1.f);
  return 0.5f * x * (1.f + t);
}
DEVINL float logsigf_(float z) { return fminf(z, 0.f) - __logf(1.f + __expf(-fabsf(z))); }
DEVINL f32x4 mfma16(bf16x8 a, bf16x8 b, f32x4 c) { return __builtin_amdgcn_mfma_f32_16x16x32_bf16(a, b, c, 0, 0, 0); }
DEVINL void glds16(const void* g, void* l) {
  __builtin_amdgcn_global_load_lds((const unsigned*)g, (unsigned*)l, 16, 0, 0);
}
DEVINL int ridx(int r) { return ((r >> 4) << 5) | (r & 15); }
constexpr size_t OFF_RSTD1X = OFF_SSF;
static_assert(OFF_SS5 == OFF_RSTD0 + al256((size_t)M * 4) && OFF_RSTD1 == OFF_SSF + al256((size_t)M * 4), "padded rstd slots");
DEVINL const float* xrow_ptr(const Params& p, int r) {
  if (r < MPROMPT) {
    int b = r / LP, t = r - b * LP;
    return (t < NMETA) ? (p.meta + (size_t)t * DM) : (p.x_prompt + ((size_t)b * SEQ + (t - NMETA)) * DM);
  }
  return p.x_sample + (size_t)(r - MPROMPT) * DM;
}
DEVINL float* outrow_ptr(const Params& p, int r) {
  if (r < MPROMPT) {
    int b = r / LP, t = r - b * LP;
    return (t < NMETA) ? nullptr : (p.out + OUT_YP + ((size_t)b * SEQ + (t - NMETA)) * DM);
  }
  return p.out + OUT_YS + (size_t)(r - MPROMPT) * DM;
}

DEVINL void tr_tile(const Params& p, char* smem, int kind, int nt, int kt) {
  float* T = (float*)smem;
  const int tid = tidx();
  const int n0 = nt * 64, k0 = kt * 64;
  const int nl = tid & 63, kq = tid >> 6;
  const int n = n0 + nl;
  const float* src = nullptr; int ld = 0, col = 0; bool valid = true; float cs = 1.f;
  const float* ksc = nullptr; int K = 1024; u16* dst = nullptr;
  if (kind == 0) {
    src = p.w_in; ld = DIN; ksc = p.g_pre_mix; dst = (u16*)(p.ws + OFF_W1T);
    if (n < 256) { col = n; cs = 0.125f; }
    else if (n < 1536) col = n;
    else if (n < 2048) col = 1552 + (n - 1536);
    else if (n < 2064) col = 1536 + (n - 2048);
    else { valid = false; col = 0; }
  } else if (kind == 1) {
    src = p.w_glu; ld = 512; col = n; K = 512; dst = (u16*)(p.ws + OFF_WGLUT);
  } else if (kind == 2) {
    src = p.w_o; ld = 1024; col = n; dst = (u16*)(p.ws + OFF_WOT);
  } else if (kind == 3) {
    int Tt = n >> 7, loc = n & 127, wn = loc >> 6, nf = (loc >> 4) & 3, c = loc & 15;
    int hidden = Tt * 64 + wn * 32 + (nf & 1) * 16 + c;
    src = (nf >= 2) ? p.w_up : p.w_gate; ld = DFF; col = hidden; ksc = p.g_pre_ffn; dst = (u16*)(p.ws + OFF_WGUT);
  } else {
    src = p.w_down; ld = 1024; col = n; K = DFF; dst = (u16*)(p.ws + OFF_WDT);
  }
  __syncthreads();
#pragma unroll 4
  for (int i = 0; i < 16; ++i) {
    int k = kq * 16 + i;
    float v = valid ? src[(size_t)(k0 + k) * ld + col] : 0.f;
    if (ksc) v *= ksc[k0 + k];
    if (kind == 2 && (k0 + k) >= 512) v *= p.s5_norm[k0 + k - 512];
    T[k * 65 + nl] = v * cs;
  }
  __syncthreads();
  const int n2 = tid >> 2, kseg = (tid & 3) * 16;
  unsigned w[8];
#pragma unroll
  for (int i = 0; i < 8; ++i) w[i] = pack2(T[(kseg + 2 * i) * 65 + n2], T[(kseg + 2 * i + 1) * 65 + n2]);
  uint4* d = (uint4*)(dst + (size_t)(n0 + n2) * K + k0 + kseg);
  d[0] = make_uint4(w[0], w[1], w[2], w[3]);
  d[1] = make_uint4(w[4], w[5], w[6], w[7]);
}

DEVINL void csq(float& r, float& i) { float nr = r * r - i * i, ni = 2.f * r * i; r = nr; i = ni; }

DEVINL void s5_param(const Params& p, int idx) {
  const int g = idx >> 6, n = idx & 63;
  float lre = fminf(p.a_re[idx], -1e-4f), lim = p.a_im[idx];
  float dt = expf(p.log_dt[g]);
  float mag = expf(lre * dt);
  float ar = mag * cosf(lim * dt), ai = mag * sinf(lim * dt);
  float den = lre * lre + lim * lim;
  float nr = ar - 1.f, ni = ai;
  float fr = (nr * lre + ni * lim) / den, fi = (ni * lre - nr * lim) / den;
  float* abar = (float*)(p.ws + OFF_ABAR);
  abar[idx * 2] = ar; abar[idx * 2 + 1] = ai;
  float p16r = ar, p16i = ai;
  for (int e = 0; e < 4; ++e) csq(p16r, p16i);
  float p256r = p16r, p256i = p16i;
  for (int e = 0; e < 4; ++e) csq(p256r, p256i);
  float* apw = (float*)(p.ws + OFF_APW);
  apw[idx * 4 + 0] = p256r; apw[idx * 4 + 1] = p256i;
  apw[idx * 4 + 2] = p256r * p16r - p256i * p16i; apw[idx * 4 + 3] = p256r * p16i + p256i * p16r;
  u16* bbt = (u16*)(p.ws + OFF_BBT);
  u16* ct = (u16*)(p.ws + OFF_CT);
  for (int j = 0; j < 16; ++j) {
    float br = p.b_re[(size_t)idx * 16 + j], bi = p.b_im[(size_t)idx * 16 + j];
    bbt[((size_t)g * 128 + 2 * n) * 16 + j] = f2bf(fr * br - fi * bi);
    bbt[((size_t)g * 128 + 2 * n + 1) * 16 + j] = f2bf(fr * bi + fi * br);
    ct[((size_t)g * 16 + j) * 128 + 2 * n] = f2bf(p.c_re[((size_t)g * 16 + j) * 64 + n]);
    ct[((size_t)g * 16 + j) * 128 + 2 * n + 1] = f2bf(-p.c_im[((size_t)g * 16 + j) * 64 + n]);
  }
}

template <int R>
DEVINL void xrow_prep(const Params& p, int r0) {
  const int lane = tidx() & 63;
  float4 v[R][4];
#pragma unroll
  for (int q = 0; q < R; ++q) {
    const float* x = xrow_ptr(p, r0 + q);
#pragma unroll
    for (int i = 0; i < 4; ++i) v[q][i] = *(const float4*)(x + i * 256 + lane * 4);
  }
#pragma unroll
  for (int q = 0; q < R; ++q) {
    u16* xb = (u16*)(p.ws + OFF_XB) + (size_t)(r0 + q) * DM;
    float ss = 0.f;
#pragma unroll
    for (int i = 0; i < 4; ++i) {
      const float4 a = v[q][i];
      ss += a.x * a.x + a.y * a.y + a.z * a.z + a.w * a.w;
      *(uint2*)(xb + i * 256 + lane * 4) = make_uint2(pack2(a.x, a.y), pack2(a.z, a.w));
    }
    ss = red16(ss); ss += __shfl_xor(ss, 16); ss += __shfl_xor(ss, 32);
    if (lane == 0) ((float*)(p.ws + OFF_RSTD0))[ridx(r0 + q)] = rsqrtf(ss * (1.f / DM) + EPS);
  }
}

constexpr int TR0 = 34 * 16, TR1 = 8 * 8, TR2 = 16 * 16, TR3 = 88 * 16, TR4 = 16 * 44;
constexpr int NTR = TR0 + TR1 + TR2 + TR3 + TR4;
constexpr int NXROW_ITEMS = M / 16;
constexpr int P0_ITEMS = NTR + NXROW_ITEMS + 8  ;

constexpr int NTR_A = TR0;
DEVINL void phase0(const Params& p, char* smem) {
  for (int it = bidx(); it < NTR_A + NXROW_ITEMS + 8; it += gridDim.x) {
    if (it < NTR_A) {
      tr_tile(p, smem, 0, it / 16, it % 16);
    } else if (it < NTR_A + NXROW_ITEMS) {
      xrow_prep<4>(p, (it - NTR_A) * 16 + (tidx() >> 6) * 4);
    } else {
      s5_param(p, (it - NTR_A - NXROW_ITEMS) * 256 + tidx());
    }
  }
}
DEVINL void mix_weight_tile(const Params& p, char* smem, int t) {
  if (t < TR1) tr_tile(p, smem, 1, t / 8, t % 8);
  else tr_tile(p, smem, 2, (t - TR1) / 16, (t - TR1) % 16);
}
DEVINL void ffn_weight_tile(const Params& p, char* smem, int t) {
  if (t < TR3) tr_tile(p, smem, 3, t / 16, t % 16);
  else tr_tile(p, smem, 4, (t - TR3) / 44, (t - TR3) % 44);
}

DEVINL void gemm_loop(f32x4 (&acc)[4][4], const u16* __restrict__ A, int lda, const u16* __restrict__ Bt, int ldb,
                      int m0, int n0, int k0, int nk, char* smem) {
  const int tid = tidx(), wid = tid >> 6, lane = tid & 63;
  const int wr = wid >> 1, wc = wid & 1;
  const u16* ga[4]; const u16* gb[4];
#pragma unroll
  for (int i = 0; i < 4; ++i) {
    int s = i * 256 + tid, r = s >> 3, c = (s & 7) ^ ((r >> 1) & 7);
    ga[i] = A + (size_t)(m0 + r) * lda + k0 + c * 8;
    gb[i] = Bt + (size_t)(n0 + r) * ldb + k0 + c * 8;
  }
  const int fr = lane & 15, fq = lane >> 4;
  __syncthreads();
#pragma unroll
  for (int i = 0; i < 4; ++i) {
    glds16(ga[i], smem + i * 4096 + wid * 1024);
    glds16(gb[i], smem + 16384 + i * 4096 + wid * 1024);
  }
  for (int kt = 0; kt < nk; ++kt) {
    __syncthreads();
    char* cur = smem + (kt & 1) * 32768;
    if (kt + 1 < nk) {
      char* nxt = smem + ((kt + 1) & 1) * 32768;
#pragma unroll
      for (int i = 0; i < 4; ++i) {
        glds16(ga[i] + (kt + 1) * 64, nxt + i * 4096 + wid * 1024);
        glds16(gb[i] + (kt + 1) * 64, nxt + 16384 + i * 4096 + wid * 1024);
      }
    }
    bf16x8 af[2][4], bfr[2][4];
#pragma unroll
    for (int ks = 0; ks < 2; ++ks)
#pragma unroll
      for (int f = 0; f < 4; ++f) {
        int ra = wr * 64 + f * 16 + fr, rb = wc * 64 + f * 16 + fr;
        int ch = ks * 4 + fq;
        af[ks][f] = *(const bf16x8*)(cur + ra * 128 + ((ch ^ ((ra >> 1) & 7)) << 4));
        bfr[ks][f] = *(const bf16x8*)(cur + 16384 + rb * 128 + ((ch ^ ((rb >> 1) & 7)) << 4));
      }
    __builtin_amdgcn_sched_barrier(0);
#pragma unroll
    for (int ks = 0; ks < 2; ++ks)
#pragma unroll
      for (int mf = 0; mf < 4; ++mf)
#pragma unroll
        for (int nf = 0; nf < 4; ++nf) acc[mf][nf] = mfma16(af[ks][mf], bfr[ks][nf], acc[mf][nf]);
  }
}

DEVINL void zero_acc(f32x4 (&acc)[4][4]) {
#pragma unroll
  for (int a = 0; a < 4; ++a)
#pragma unroll
    for (int b = 0; b < 4; ++b) acc[a][b] = f32x4{0.f, 0.f, 0.f, 0.f};
}

DEVINL void row_ss_atomic(float s, float* dst) {
  s += __shfl_xor(s, 1); s += __shfl_xor(s, 2); s += __shfl_xor(s, 4); s += __shfl_xor(s, 8);
  if ((tidx() & 15) == 0) unsafeAtomicAdd(dst, s);
}

DEVINL void p1_tile(const Params& p, char* smem, int mt, int nt) {
  f32x4 acc[4][4]; zero_acc(acc);
  const int m0 = mt * 128, n0 = nt * 128;
  gemm_loop(acc, (const u16*)(p.ws + OFF_XB), 1024, (const u16*)(p.ws + OFF_W1T), 1024, m0, n0, 0, 16, smem);
  const int lane = tidx() & 63, wid = tidx() >> 6, wr = wid >> 1, wc = wid & 1;
  const float* rstd0 = (const float*)(p.ws + OFF_RSTD0);
  u16* qk = (u16*)(p.ws + OFF_QK); u16* kT = (u16*)(p.ws + OFF_KT); u16* vT = (u16*)(p.ws + OFF_VT);
  u16* gb = (u16*)(p.ws + OFF_GB); u16* ub = (u16*)(p.ws + OFF_UB); float* gk = (float*)(p.ws + OFF_GK);
#pragma unroll
  for (int mf = 0; mf < 4; ++mf) {
    const int rb = m0 + wr * 64 + mf * 16 + (lane >> 4) * 4;
    float rs[4];
#pragma unroll
    for (int j = 0; j < 4; ++j) rs[j] = rstd0[ridx(rb) + j];
#pragma unroll
    for (int nf = 0; nf < 4; ++nf) {
      const int col = n0 + wc * 64 + nf * 16 + (lane & 15);
      float v[4];
#pragma unroll
      for (int j = 0; j < 4; ++j) v[j] = acc[mf][nf][j] * rs[j];
      if (nt < 4) {
        store_pairs(qk, 512, rb, col, v[0], v[1], v[2], v[3]);
        if (nt >= 2) *(uint2*)(kT + (size_t)(col - 256) * LDT + rb) = make_uint2(pack2(v[0], v[1]), pack2(v[2], v[3]));
      } else if (nt < 8) {
        *(uint2*)(vT + (size_t)(col - 512) * LDT + rb) = make_uint2(pack2(v[0], v[1]), pack2(v[2], v[3]));
      } else if (nt < 12) {
        store_pairs(gb, 512, rb, col - 1024, v[0], v[1], v[2], v[3]);
      } else if (nt < 16) {
        store_pairs(ub, 512, rb, col - 1536, v[0], v[1], v[2], v[3]);
      } else if (col < 2064) {
#pragma unroll
        for (int j = 0; j < 4; ++j) gk[(size_t)(rb + j) * 16 + (col - 2048)] = v[j];
      }
    }
  }
}

DEVINL void p3_tile(const Params& p, char* smem, int mt, int nt) {
  f32x4 acc[4][4]; zero_acc(acc);
  const int m0 = mt * 128, n0 = nt * 128;
  const u16* yg = (const u16*)(p.ws + OFF_YG);
  gemm_loop(acc, yg, 512, (const u16*)(p.ws + OFF_WGLUT), 512, m0, n0, 0, 8, smem);
  const int lane = tidx() & 63, wid = tidx() >> 6, wr = wid >> 1, wc = wid & 1;
  u16* mixin = (u16*)(p.ws + OFF_MIXIN);
#pragma unroll
  for (int mf = 0; mf < 4; ++mf) {
    const int rb = m0 + wr * 64 + mf * 16 + (lane >> 4) * 4;
    float ssq[4] = {0.f, 0.f, 0.f, 0.f};
#pragma unroll
    for (int nf = 0; nf < 4; ++nf) {
      const int col = n0 + wc * 64 + nf * 16 + (lane & 15);
      float val[4];
#pragma unroll
      for (int j = 0; j < 4; ++j) {
        val[j] = bf2f(yg[(size_t)(rb + j) * 512 + col]) * sigmoidf_(acc[mf][nf][j]);
        ssq[j] += val[j] * val[j];
      }
      store_pairs(mixin, 1024, rb, 512 + col, val[0], val[1], val[2], val[3]);
    }
    {
      float* ss5p = (float*)(p.ws + OFF_SS5P);
#pragma unroll
      for (int j = 0; j < 4; ++j) {
        const float v = red16(ssq[j]);
        if ((lane & 15) == 0) ss5p[((size_t)nt * M + rb + j) * 2 + wc] = v;
      }
    }
  }
}

DEVINL void p4_tile(const Params& p, char* smem, int mt, int nt) {
  f32x4 acc[4][4]; zero_acc(acc);
  const int m0 = mt * 128, n0 = nt * 128;
  const u16* mixin = (const u16*)(p.ws + OFF_MIXIN); const u16* wot = (const u16*)(p.ws + OFF_WOT);
  gemm_loop(acc, mixin, 1024, wot, 1024, m0, n0, 512, 8, smem);
  const int lane = tidx() & 63, wid = tidx() >> 6, wr = wid >> 1, wc = wid & 1;
  {
    const int tid = tidx(), row = tid >> 1, half = tid & 1;
    const float* ss5p = (const float*)(p.ws + OFF_SS5P);
    float ssq = 0.f;
#pragma unroll
    for (int q = 0; q < 2; ++q) {
      const float2 v = *(const float2*)(ss5p + ((size_t)(half * 2 + q) * M + m0 + row) * 2);
      ssq += v.x + v.y;
    }
    ssq += lane_xor1(ssq);
    __syncthreads();
    float* rs5 = (float*)smem;
    if (half == 0) rs5[row] = rsqrtf(ssq * (1.f / 512.f) + EPS);
    __syncthreads();
#pragma unroll
    for (int mf = 0; mf < 4; ++mf) {
      const int rl = wr * 64 + mf * 16 + (lane >> 4) * 4;
#pragma unroll
      for (int j = 0; j < 4; ++j) {
        const float rs = rs5[rl + j];
#pragma unroll
        for (int nf = 0; nf < 4; ++nf) acc[mf][nf][j] *= rs;
      }
    }
  }
  gemm_loop(acc, mixin, 1024, wot, 1024, m0, n0, 0, 8, smem);
  u16* mixo = (u16*)(p.ws + OFF_MIXO);
#pragma unroll
  for (int mf = 0; mf < 4; ++mf) {
    const int rb = m0 + wr * 64 + mf * 16 + (lane >> 4) * 4;
#pragma unroll
    for (int nf = 0; nf < 4; ++nf) {
      const int col = n0 + wc * 64 + nf * 16 + (lane & 15);
      store_pairs(mixo, 1024, rb, col, acc[mf][nf][0], acc[mf][nf][1], acc[mf][nf][2], acc[mf][nf][3]);
    }
  }
}

DEVINL void p6_tile(const Params& p, char* smem, int mt, int nt) {
  f32x4 acc[4][4]; zero_acc(acc);
  const int m0 = mt * 128, n0 = nt * 128;
  gemm_loop(acc, (const u16*)(p.ws + OFF_X1B), 1024, (const u16*)(p.ws + OFF_WGUT), 1024, m0, n0, 0, 16, smem);
  const int lane = tidx() & 63, wid = tidx() >> 6, wr = wid >> 1, wc = wid & 1;
  const float* rstd1 = (const float*)(p.ws + OFF_RSTD1X);
  u16* actb = (u16*)(p.ws + OFF_ACTB);
#pragma unroll
  for (int mf = 0; mf < 4; ++mf) {
    const int rb = m0 + wr * 64 + mf * 16 + (lane >> 4) * 4;
    float rs[4];
#pragma unroll
    for (int j = 0; j < 4; ++j) rs[j] = rstd1[ridx(rb) + j];
#pragma unroll
    for (int nf = 0; nf < 2; ++nf) {
      const int hid = nt * 64 + wc * 32 + nf * 16 + (lane & 15);
      float a[4];
#pragma unroll
      for (int j = 0; j < 4; ++j) {
        float g = acc[mf][nf][j] * rs[j], u = acc[mf][nf + 2][j] * rs[j];
        a[j] = siluf_(g) * u;
      }
      store_pairs(actb, DFF, rb, hid, a[0], a[1], a[2], a[3]);
    }
  }
}

DEVINL void p7_tile(const Params& p, char* smem, int mt, int ntp) {
  f32x4 acc[4][4]; zero_acc(acc);
  const int khalf = ntp >> 3, nt = ntp & 7;
  const int m0 = mt * 128, n0 = nt * 128;
  gemm_loop(acc, (const u16*)(p.ws + OFF_ACTB), DFF, (const u16*)(p.ws + OFF_WDT), DFF, m0, n0, khalf * (DFF / 2), 22, smem);
  const int lane = tidx() & 63, wid = tidx() >> 6, wr = wid >> 1, wc = wid & 1;
  u16* fb = (u16*)(p.ws + (khalf ? OFF_FB1 : OFF_FB));
#pragma unroll
  for (int mf = 0; mf < 4; ++mf) {
    const int rb = m0 + wr * 64 + mf * 16 + (lane >> 4) * 4;
#pragma unroll
    for (int nf = 0; nf < 4; ++nf) {
      const int col = n0 + wc * 64 + nf * 16 + (lane & 15);
      store_pairs(fb, 1024, rb, col, acc[mf][nf][0], acc[mf][nf][1], acc[mf][nf][2], acc[mf][nf][3]);
    }
  }
}

struct ChunkInfo { int r0, T, h; };
DEVINL ChunkInfo chunk_info(int item) {
  ChunkInfo ci;
  if (item < NCH_P) {
    int bh = item / 33, c = item - bh * 33, b = bh >> 2;
    ci.h = bh & 3;
    if (c == 0) { ci.r0 = b * LP; ci.T = 16; }
    else { ci.r0 = b * LP + 16 + 64 * (c - 1); ci.T = 64; }
  } else {
    int bh = item - NCH_P, b = bh >> 2;
    ci.h = bh & 3; ci.r0 = MPROMPT + 8 * b; ci.T = 8;
  }
  return ci;
}

constexpr int G_GKL = 0, G_BC = 4096, G_TOT = 20736, G_BL = 21760, G_QD = 22016, G_KI = 31232, G_ATT = 40448, G_RED = 49664;

DEVINL void gla_prep(const Params& p, char* smem, int r0, int T, int h, float (&bcum)[16]) {
  float* gkl = (float*)(smem + G_GKL); float* Bc = (float*)(smem + G_BC);
  float* tot = (float*)(smem + G_TOT); float* bl = (float*)(smem + G_BL);
  const int tid = tidx(), lane = tid & 63, w = tid >> 6;
  const float* gk = (const float*)(p.ws + OFF_GK);
  __syncthreads();
  {
    int t = tid >> 2, c4 = (tid & 3) * 4;
    const float4 v = *(const float4*)(gk + (size_t)(r0 + t) * 16 + c4);
    *(float4*)(gkl + t * 16 + c4) = v;
  }
  float wreg[16];
#pragma unroll
  for (int r = 0; r < 16; ++r) wreg[r] = p.w_gk2[r * 256 + h * 64 + lane];
  const float bias = p.b_gk[h * 64 + lane];
  __syncthreads();
  float run = 0.f;
#pragma unroll
  for (int i = 0; i < 16; ++i) {
    const int t = 16 * w + i;
    float z = bias;
#pragma unroll
    for (int r4 = 0; r4 < 4; ++r4) {
      float4 gv = *(const float4*)(gkl + t * 16 + r4 * 4);
      z += gv.x * wreg[r4 * 4] + gv.y * wreg[r4 * 4 + 1] + gv.z * wreg[r4 * 4 + 2] + gv.w * wreg[r4 * 4 + 3];
    }
    float lg = (t < T) ? logsigf_(z) * (1.f / 16.f) : 0.f;
    run += lg;
    bcum[i] = run;
  }
  tot[w * 64 + lane] = run;
  __syncthreads();
  float off = 0.f, total = 0.f;
#pragma unroll
  for (int w2 = 0; w2 < 4; ++w2) { float v = tot[w2 * 64 + lane]; if (w2 < w) off += v; total += v; }
#pragma unroll
  for (int i = 0; i < 16; ++i) { bcum[i] += off; Bc[(16 * w + i) * 65 + lane] = bcum[i]; }
  if (w == 0) bl[lane] = total;
  __syncthreads();
}

DEVINL void gla_passA(const Params& p, char* smem, int item) {
  const ChunkInfo ci = chunk_info(item);
  const int tid = tidx(), lane = tid & 63, w = tid >> 6;
  const u16* kT = (const u16*)(p.ws + OFF_KT); const u16* vT = (const u16*)(p.ws + OFF_VT);
  bf16x8 kr[2][4], vb[2][2];
#pragma unroll
  for (int ks = 0; ks < 2; ++ks) {
    const int tb = ks * 32 + 8 * (lane >> 4);
#pragma unroll
    for (int nf = 0; nf < 2; ++nf)
      vb[ks][nf] = *(const bf16x8*)(vT + (size_t)(ci.h * 128 + 32 * w + nf * 16 + (lane & 15)) * LDT + ci.r0 + tb);
#pragma unroll
    for (int mf = 0; mf < 4; ++mf)
      kr[ks][mf] = *(const bf16x8*)(kT + (size_t)(ci.h * 64 + mf * 16 + (lane & 15)) * LDT + ci.r0 + tb);
  }
  float bcum[16];
  gla_prep(p, smem, ci.r0, ci.T, ci.h, bcum);
  {
    float* bc = (float*)(p.ws + OFF_BCUM) + (size_t)item * 4096;
#pragma unroll
    for (int i = 0; i < 16; ++i) bc[(16 * w + i) * 64 + lane] = bcum[i];
  }
  const float* Bc = (const float*)(smem + G_BC); const float* bl = (const float*)(smem + G_BL);
  f32x4 acc[4][2];
#pragma unroll
  for (int a = 0; a < 4; ++a) { acc[a][0] = f32x4{0, 0, 0, 0}; acc[a][1] = f32x4{0, 0, 0, 0}; }
#pragma unroll
  for (int ks = 0; ks < 2; ++ks) {
    const int tb = ks * 32 + 8 * (lane >> 4);
    bf16x8 bfr[2];
#pragma unroll
    for (int nf = 0; nf < 2; ++nf) bfr[nf] = vb[ks][nf];
#pragma unroll
    for (int mf = 0; mf < 4; ++mf) {
      const int d = mf * 16 + (lane & 15);
      const bf16x8 kraw = kr[ks][mf];
      const float bld = bl[d];
      bf16x8 afr;
#pragma unroll
      for (int j = 0; j < 8; ++j) {
        int t = tb + j;
        float e = __expf(bld - Bc[t * 65 + d]);
        afr[j] = (t < ci.T) ? (short)f2bf(bf2f((u16)kraw[j]) * e) : (short)0;
      }
#pragma unroll
      for (int nf = 0; nf < 2; ++nf) acc[mf][nf] = mfma16(afr, bfr[nf], acc[mf][nf]);
    }
  }
  float* dS = (float*)(p.ws + OFF_DS) + (size_t)item * 8192;
#pragma unroll
  for (int mf = 0; mf < 4; ++mf)
#pragma unroll
    for (int nf = 0; nf < 2; ++nf)
#pragma unroll
      for (int j = 0; j < 4; ++j) {
        int d = mf * 16 + (lane >> 4) * 4 + j, dv = 32 * w + nf * 16 + (lane & 15);
        dS[d * 128 + dv] = acc[mf][nf][j];
      }
  if (w == 0) ((float*)(p.ws + OFF_DECAY))[(size_t)item * 64 + lane] = __expf(bl[lane]);
}

DEVINL void gla_passB(const Params& p, int idx) {
  const int chain = idx >> 2, dvg = idx & 3;
  const int tid = tidx(), dv = dvg * 32 + (tid & 31), d0 = (tid >> 5) * 8;
  float S[8];
  int item0, nchunks; float* outp;
  if (chain < 32) {
    item0 = chain * 33; nchunks = 33;
    outp = p.out + OUT_GP + (size_t)chain * 8192;
#pragma unroll
    for (int i = 0; i < 8; ++i) S[i] = 0.f;
  } else {
    int bh = chain - 32;
    item0 = NCH_P + bh; nchunks = 1;
    outp = p.out + OUT_GS + (size_t)bh * 8192;
#pragma unroll
    for (int i = 0; i < 8; ++i) S[i] = p.state_gla[(size_t)bh * 8192 + (d0 + i) * 128 + dv];
  }
  const float* dS = (const float*)(p.ws + OFF_DS); const float* decay = (const float*)(p.ws + OFF_DECAY);
  u16* SpT = (u16*)(p.ws + OFF_SPT);
  const float* dSb = dS + (size_t)item0 * 8192 + d0 * 128 + dv;
  const float* dcb = decay + (size_t)item0 * 64 + d0;
  u16* spb = SpT + (size_t)item0 * 8192 + dv * 64 + d0;
  int c = 0;
  for (; c + 4 <= nchunks; c += 4) {
    float v[4][8], dc[4][8];
#pragma unroll
    for (int q = 0; q < 4; ++q)
#pragma unroll
      for (int i = 0; i < 8; ++i) { v[q][i] = dSb[(size_t)(c + q) * 8192 + i * 128]; dc[q][i] = dcb[(c + q) * 64 + i]; }
#pragma unroll
    for (int q = 0; q < 4; ++q) {
      *(uint4*)(spb + (size_t)(c + q) * 8192) =
          make_uint4(pack2(S[0], S[1]), pack2(S[2], S[3]), pack2(S[4], S[5]), pack2(S[6], S[7]));
#pragma unroll
      for (int i = 0; i < 8; ++i) S[i] = dc[q][i] * S[i] + v[q][i];
    }
  }
  for (; c < nchunks; ++c) {
    float v[8], dc[8];
#pragma unroll
    for (int i = 0; i < 8; ++i) { v[i] = dSb[(size_t)c * 8192 + i * 128]; dc[i] = dcb[c * 64 + i]; }
    *(uint4*)(spb + (size_t)c * 8192) =
        make_uint4(pack2(S[0], S[1]), pack2(S[2], S[3]), pack2(S[4], S[5]), pack2(S[6], S[7]));
#pragma unroll
    for (int i = 0; i < 8; ++i) S[i] = dc[i] * S[i] + v[i];
  }
#pragma unroll
  for (int i = 0; i < 8; ++i) outp[(d0 + i) * 128 + dv] = S[i];
}

DEVINL void gla_passC(const Params& p, char* smem, int item) {
  const ChunkInfo ci = chunk_info(item);
  const int tid = tidx(), lane = tid & 63, w = tid >> 6;
  const u16* qk = (const u16*)(p.ws + OFF_QK);
  const u16* vT = (const u16*)(p.ws + OFF_VT);
  const u16* SpT = (const u16*)(p.ws + OFF_SPT) + (size_t)item * 8192;
  const u16* gbuf = (const u16*)(p.ws + OFF_GB);
  u16 qraw[16], kraw16[16];
#pragma unroll
  for (int i = 0; i < 16; ++i) {
    const int t = 16 * w + i;
    qraw[i] = qk[(size_t)(ci.r0 + t) * 512 + ci.h * 64 + lane];
    kraw16[i] = qk[(size_t)(ci.r0 + t) * 512 + 256 + ci.h * 64 + lane];
  }
  bf16x8 bvv[2][2], bss[2][2];
#pragma unroll
  for (int ks = 0; ks < 2; ++ks) {
    const int kb = ks * 32 + 8 * (lane >> 4);
#pragma unroll
    for (int nf = 0; nf < 2; ++nf) {
      const int dv = 32 * w + nf * 16 + (lane & 15);
      bvv[ks][nf] = *(const bf16x8*)(vT + (size_t)(ci.h * 128 + dv) * LDT + ci.r0 + kb);
      bss[ks][nf] = *(const bf16x8*)(SpT + dv * 64 + kb);
    }
  }
  u16 graw[4][2][4];
#pragma unroll
  for (int mf = 0; mf < 4; ++mf) {
    const int t0 = mf * 16 + (lane >> 4) * 4;
#pragma unroll
    for (int nf = 0; nf < 2; ++nf)
#pragma unroll
      for (int j = 0; j < 4; ++j)
        graw[mf][nf][j] = gbuf[(size_t)(ci.r0 + t0 + j) * 512 + ci.h * 128 + 32 * w + nf * 16 + (lane & 15)];
  }
  float bcum[16];
  {
    const float* bc = (const float*)(p.ws + OFF_BCUM) + (size_t)item * 4096;
#pragma unroll
    for (int i = 0; i < 16; ++i) bcum[i] = bc[(16 * w + i) * 64 + lane];
  }
  __syncthreads();
  u16* Qd = (u16*)(smem + G_QD); u16* Ki = (u16*)(smem + G_KI); u16* Att = (u16*)(smem + G_ATT);
  float* red = (float*)(smem + G_RED);
#pragma unroll
  for (int i = 0; i < 16; ++i) {
    const int t = 16 * w + i;
    const float qv = (t < ci.T) ? bf2f(qraw[i]) : 0.f, kv = (t < ci.T) ? bf2f(kraw16[i]) : 0.f;
    const float bt = bcum[i];
    Qd[t * 72 + lane] = f2bf(qv * __expf(bt));
    Ki[t * 72 + lane] = f2bf(kv * __expf(-bt));
  }
  __syncthreads();
  {
    f32x4 at[4];
#pragma unroll
    for (int nf = 0; nf < 4; ++nf) at[nf] = f32x4{0, 0, 0, 0};
#pragma unroll
    for (int ks = 0; ks < 2; ++ks) {
      bf16x8 a = *(const bf16x8*)(Qd + (16 * w + (lane & 15)) * 72 + ks * 32 + 8 * (lane >> 4));
#pragma unroll
      for (int nf = 0; nf < 4; ++nf) {
        bf16x8 b = *(const bf16x8*)(Ki + (nf * 16 + (lane & 15)) * 72 + ks * 32 + 8 * (lane >> 4));
        at[nf] = mfma16(a, b, at[nf]);
      }
    }
#pragma unroll
    for (int nf = 0; nf < 4; ++nf)
#pragma unroll
      for (int j = 0; j < 4; ++j) {
        int t = 16 * w + (lane >> 4) * 4 + j, s = nf * 16 + (lane & 15);
        Att[t * 72 + s] = f2bf((s <= t) ? at[nf][j] : 0.f);
      }
  }
  __syncthreads();
  f32x4 o[4][2];
#pragma unroll
  for (int a = 0; a < 4; ++a) { o[a][0] = f32x4{0, 0, 0, 0}; o[a][1] = f32x4{0, 0, 0, 0}; }
#pragma unroll
  for (int ks = 0; ks < 2; ++ks) {
    const int kb = ks * 32 + 8 * (lane >> 4);
    bf16x8 bv[2], bs[2];
#pragma unroll
    for (int nf = 0; nf < 2; ++nf) { bv[nf] = bvv[ks][nf]; bs[nf] = bss[ks][nf]; }
#pragma unroll
    for (int mf = 0; mf < 4; ++mf) {
      bf16x8 aa = *(const bf16x8*)(Att + (mf * 16 + (lane & 15)) * 72 + kb);
      bf16x8 aq = *(const bf16x8*)(Qd + (mf * 16 + (lane & 15)) * 72 + kb);
#pragma unroll
      for (int nf = 0; nf < 2; ++nf) {
        o[mf][nf] = mfma16(aa, bv[nf], o[mf][nf]);
        o[mf][nf] = mfma16(aq, bs[nf], o[mf][nf]);
      }
    }
  }
#pragma unroll
  for (int mf = 0; mf < 4; ++mf)
#pragma unroll
    for (int j = 0; j < 4; ++j) {
      const float s = red16(o[mf][0][j] * o[mf][0][j] + o[mf][1][j] * o[mf][1][j]);
      red[w * 64 + mf * 16 + (lane >> 4) * 4 + j] = s;
    }
  __syncthreads();
  u16* mixin = (u16*)(p.ws + OFF_MIXIN);
  float gn[2];
#pragma unroll
  for (int nf = 0; nf < 2; ++nf) gn[nf] = p.gla_norm[32 * w + nf * 16 + (lane & 15)];
#pragma unroll
  for (int mf = 0; mf < 4; ++mf) {
    const int t0 = mf * 16 + (lane >> 4) * 4;
    if (t0 < ci.T) {
      float rs[4];
#pragma unroll
      for (int j = 0; j < 4; ++j) {
        const int t = t0 + j;
        rs[j] = rsqrtf((red[t] + red[64 + t] + red[128 + t] + red[192 + t]) * (1.f / 128.f) + EPS);
      }
#pragma unroll
      for (int nf = 0; nf < 2; ++nf) {
        const int dv = 32 * w + nf * 16 + (lane & 15);
        float o4[4];
#pragma unroll
        for (int j = 0; j < 4; ++j) {
          float gv = bf2f(graw[mf][nf][j]);
          o4[j] = o[mf][nf][j] * rs[j] * gn[nf] * siluf_(gv);
        }
        store_pairs(mixin, 1024, ci.r0 + t0, ci.h * 128 + dv, o4[0], o4[1], o4[2], o4[3]);
      }
    }
  }
}

DEVINL void s5_seg(const Params& p, char* wsm, int rb, int ntok, int g, float& hr, float& hi, bool outp) {
  const int lane = tidx() & 63;
  float* BUs = (float*)wsm;
  u16* Hs = (u16*)(wsm + 8448);
  const float2 ab = ((const float2*)(p.ws + OFF_ABAR))[g * 64 + lane];
  const u16* bbt = (const u16*)(p.ws + OFF_BBT); const u16* ct = (const u16*)(p.ws + OFF_CT);
  const u16* ub = (const u16*)(p.ws + OFF_UB); u16* yg = (u16*)(p.ws + OFF_YG);
  const bf16x8 zero8 = {0, 0, 0, 0, 0, 0, 0, 0};
  bf16x8 bb[8];
#pragma unroll
  for (int nf = 0; nf < 8; ++nf)
    bb[nf] = ((lane >> 4) < 2) ? *(const bf16x8*)(bbt + ((size_t)g * 128 + nf * 16 + (lane & 15)) * 16 + 8 * (lane >> 4)) : zero8;
  bf16x8 cm[4];
#pragma unroll
  for (int ks = 0; ks < 4; ++ks)
    cm[ks] = *(const bf16x8*)(ct + ((size_t)g * 16 + (lane & 15)) * 128 + ks * 32 + 8 * (lane >> 4));
  const float dsk = p.s5_d[g * 16 + (lane & 15)];
  const int tk0 = (lane >> 4) * 4, ucol = g * 16 + (lane & 15);
  bf16x8 a_nxt = zero8;
  u16 u_nxt[4] = {0, 0, 0, 0};
  {
    const int nt0 = min(16, ntok);
    if ((lane >> 4) < 2 && (lane & 15) < nt0)
      a_nxt = *(const bf16x8*)(ub + (size_t)(rb + (lane & 15)) * 512 + g * 16 + 8 * (lane >> 4));
    if (outp && tk0 < nt0) {
#pragma unroll
      for (int j = 0; j < 4; ++j) u_nxt[j] = ub[(size_t)(rb + tk0 + j) * 512 + ucol];
    }
  }
  for (int t0 = 0; t0 < ntok; t0 += 16) {
    const int nt = min(16, ntok - t0);
    const bf16x8 a = a_nxt;
    u16 u_cur[4];
#pragma unroll
    for (int j = 0; j < 4; ++j) u_cur[j] = u_nxt[j];
    if (t0 + 16 < ntok) {
      const int ntn = min(16, ntok - t0 - 16);
      a_nxt = zero8;
      if ((lane >> 4) < 2 && (lane & 15) < ntn)
        a_nxt = *(const bf16x8*)(ub + (size_t)(rb + t0 + 16 + (lane & 15)) * 512 + g * 16 + 8 * (lane >> 4));
      if (outp && tk0 < ntn) {
#pragma unroll
        for (int j = 0; j < 4; ++j) u_nxt[j] = ub[(size_t)(rb + t0 + 16 + tk0 + j) * 512 + ucol];
      }
    }
#pragma unroll
    for (int nf = 0; nf < 8; ++nf) {
      f32x4 c = mfma16(a, bb[nf], f32x4{0, 0, 0, 0});
#pragma unroll
      for (int j = 0; j < 4; ++j) BUs[((lane >> 4) * 4 + j) * 132 + nf * 16 + (lane & 15)] = c[j];
    }
    __builtin_amdgcn_wave_barrier();
    asm volatile("s_waitcnt lgkmcnt(0)" ::: "memory");
    if (nt == 16) {
      float2 bu[16];
#pragma unroll
      for (int t = 0; t < 16; ++t) bu[t] = *(const float2*)(BUs + t * 132 + 2 * lane);
#pragma unroll
      for (int t = 0; t < 16; ++t) {
        float nr = ab.x * hr - ab.y * hi + bu[t].x;
        float ni = ab.x * hi + ab.y * hr + bu[t].y;
        hr = nr; hi = ni;
        if (outp) *(unsigned*)(Hs + t * 136 + 2 * lane) = pack2(hr, hi);
      }
    } else {
      for (int t = 0; t < nt; ++t) {
        float2 bu = *(const float2*)(BUs + t * 132 + 2 * lane);
        float nr = ab.x * hr - ab.y * hi + bu.x;
        float ni = ab.x * hi + ab.y * hr + bu.y;
        hr = nr; hi = ni;
        if (outp) *(unsigned*)(Hs + t * 136 + 2 * lane) = pack2(hr, hi);
      }
    }
    __builtin_amdgcn_wave_barrier();
    asm volatile("s_waitcnt lgkmcnt(0)" ::: "memory");
    if (outp) {
      f32x4 y = f32x4{0, 0, 0, 0};
#pragma unroll
      for (int ks = 0; ks < 4; ++ks) {
        bf16x8 ha = *(const bf16x8*)(Hs + (lane & 15) * 136 + ks * 32 + 8 * (lane >> 4));
        y = mfma16(ha, cm[ks], y);
      }
      if (tk0 < nt) {
        float yv[4];
#pragma unroll
        for (int j = 0; j < 4; ++j) yv[j] = geluf_(y[j] + dsk * bf2f(u_cur[j]));
        store_pairs(yg, 512, rb + t0 + tk0, ucol, yv[0], yv[1], yv[2], yv[3]);
      }
      __builtin_amdgcn_wave_barrier();
      asm volatile("s_waitcnt lgkmcnt(0)" ::: "memory");
    }
  }
}

DEVINL void seg_rows(int b, int s, int& rb, int& ntok) {
  if (s == 0) { rb = b * LP; ntok = 272; } else { rb = b * LP + 272 + 256 * (s - 1); ntok = 256; }
}

DEVINL void s5_passA(const Params& p, char* smem, int item) {
  const int lane = tidx() & 63, wid = tidx() >> 6;
  const int bq = item / 7, s = item - bq * 7, b = bq >> 3, g = (bq & 7) * 4 + wid;
  const int bg = b * 32 + g;
  int rb, ntok; seg_rows(b, s, rb, ntok);
  float hr = 0.f, hi = 0.f;
  s5_seg(p, smem + wid * 12800, rb, ntok, g, hr, hi, false);
  ((float2*)(p.ws + OFF_HEND))[((size_t)bg * 7 + s) * 64 + lane] = make_float2(hr, hi);
}

DEVINL void s5_passC_prompt(const Params& p, char* smem, int item) {
  const int lane = tidx() & 63, wid = tidx() >> 6;
  const int bq = item >> 3, s = item & 7, b = bq >> 3, g = (bq & 7) * 4 + wid;
  const int bg = b * 32 + g;
  int rb, ntok; seg_rows(b, s, rb, ntok);
  float hr = 0.f, hi = 0.f;
  const float4 pw = ((const float4*)(p.ws + OFF_APW))[g * 64 + lane];
  const float2* hend = (const float2*)(p.ws + OFF_HEND);
  for (int s2 = 0; s2 < s; ++s2) {
    float pr = (s2 == 0) ? pw.z : pw.x, pi = (s2 == 0) ? pw.w : pw.y;
    float2 he = hend[((size_t)bg * 7 + s2) * 64 + lane];
    float nr = pr * hr - pi * hi + he.x, ni = pr * hi + pi * hr + he.y;
    hr = nr; hi = ni;
  }
  s5_seg(p, smem + wid * 12800, rb, ntok, g, hr, hi, true);
  if (s == 7) {
    p.out[OUT_RP + (size_t)bg * 64 + lane] = hr;
    p.out[OUT_IP + (size_t)bg * 64 + lane] = hi;
  }
}

DEVINL void s5_passC_sample(const Params& p, char* smem, int item) {
  const int lane = tidx() & 63, wid = tidx() >> 6;
  const int b = item >> 3, g = (item & 7) * 4 + wid;
  const int wi = b * 32 + g;
  float hr = p.s5r0[(size_t)wi * 64 + lane], hi = p.s5i0[(size_t)wi * 64 + lane];
  s5_seg(p, smem + wid * 12800, MPROMPT + 8 * b, 8, g, hr, hi, true);
  p.out[OUT_RS + (size_t)wi * 64 + lane] = hr;
  p.out[OUT_IS + (size_t)wi * 64 + lane] = hi;
}

DEVINL float wave_sum(float v) {
  v = red16(v);
  v += __shfl_xor(v, 16);
  v += __shfl_xor(v, 32);
  return v;
}
DEVINL void unpack4(uint2 q, float (&f)[4]) {
  f[0] = bf2f((u16)(q.x & 0xffff)); f[1] = bf2f((u16)(q.x >> 16));
  f[2] = bf2f((u16)(q.y & 0xffff)); f[3] = bf2f((u16)(q.y >> 16));
}
template <int R>
DEVINL void p5_rows(const Params& p, int r0) {
  const int lane = tidx() & 63;
  float4 xv[R][4]; uint2 mq[R][4];
#pragma unroll
  for (int q = 0; q < R; ++q) {
    const float* x = xrow_ptr(p, r0 + q);
    const u16* mo = (const u16*)(p.ws + OFF_MIXO) + (size_t)(r0 + q) * DM;
#pragma unroll
    for (int i = 0; i < 4; ++i) { xv[q][i] = *(const float4*)(x + i * 256 + lane * 4); mq[q][i] = *(const uint2*)(mo + i * 256 + lane * 4); }
  }
  float4 g[4];
#pragma unroll
  for (int i = 0; i < 4; ++i) g[i] = *(const float4*)(p.g_post_mix + i * 256 + lane * 4);
#pragma unroll
  for (int q = 0; q < R; ++q) {
    float m[4][4];
    float ssm = 0.f;
#pragma unroll
    for (int i = 0; i < 4; ++i) {
      unpack4(mq[q][i], m[i]);
      ssm += m[i][0] * m[i][0] + m[i][1] * m[i][1] + m[i][2] * m[i][2] + m[i][3] * m[i][3];
    }
    const float rsm = rsqrtf(wave_sum(ssm) * (1.f / DM) + EPS);
    u16* x1b = (u16*)(p.ws + OFF_X1B) + (size_t)(r0 + q) * DM;
    float ss = 0.f;
#pragma unroll
    for (int i = 0; i < 4; ++i) {
      const float4 v = xv[q][i];
      float a0 = v.x + m[i][0] * rsm * g[i].x, a1 = v.y + m[i][1] * rsm * g[i].y;
      float a2 = v.z + m[i][2] * rsm * g[i].z, a3 = v.w + m[i][3] * rsm * g[i].w;
      ss += a0 * a0 + a1 * a1 + a2 * a2 + a3 * a3;
      *(uint2*)(x1b + i * 256 + lane * 4) = make_uint2(pack2(a0, a1), pack2(a2, a3));
    }
    ss = wave_sum(ss);
    if (lane == 0) {
      ((float*)(p.ws + OFF_RSTD1X))[ridx(r0 + q)] = rsqrtf(ss * (1.f / DM) + EPS);
    }
  }
}

template <int R>
DEVINL void p8_rows(const Params& p, int r0) {
  const int lane = tidx() & 63;
  uint2 xq[R][4], fq0[R][4], fq1[R][4];
  float* op[R];
#pragma unroll
  for (int q = 0; q < R; ++q) {
    op[q] = outrow_ptr(p, r0 + q);
    const u16* x1 = (const u16*)(p.ws + OFF_X1B) + (size_t)(r0 + q) * DM;
    const u16* f0 = (const u16*)(p.ws + OFF_FB) + (size_t)(r0 + q) * DM;
    const u16* f1 = (const u16*)(p.ws + OFF_FB1) + (size_t)(r0 + q) * DM;
#pragma unroll
    for (int i = 0; i < 4; ++i) {
      const int c = i * 256 + lane * 4;
      xq[q][i] = *(const uint2*)(x1 + c);
      fq0[q][i] = *(const uint2*)(f0 + c); fq1[q][i] = *(const uint2*)(f1 + c);
    }
  }
  float4 g2[4];
#pragma unroll
  for (int i = 0; i < 4; ++i) g2[i] = *(const float4*)(p.g_post_ffn + i * 256 + lane * 4);
#pragma unroll
  for (int q = 0; q < R; ++q) {
    if (!op[q]) continue;
    float f[4][4];
    float ssf = 0.f;
#pragma unroll
    for (int i = 0; i < 4; ++i) {
      float f1[4];
      unpack4(fq0[q][i], f[i]); unpack4(fq1[q][i], f1);
      f[i][0] += f1[0]; f[i][1] += f1[1]; f[i][2] += f1[2]; f[i][3] += f1[3];
      ssf += f[i][0] * f[i][0] + f[i][1] * f[i][1] + f[i][2] * f[i][2] + f[i][3] * f[i][3];
    }
    const float rsf = rsqrtf(wave_sum(ssf) * (1.f / DM) + EPS);
#pragma unroll
    for (int i = 0; i < 4; ++i) {
      float x1v[4];
      unpack4(xq[q][i], x1v);
      float4 r4;
      r4.x = x1v[0] + f[i][0] * rsf * g2[i].x;
      r4.y = x1v[1] + f[i][1] * rsf * g2[i].y;
      r4.z = x1v[2] + f[i][2] * rsf * g2[i].z;
      r4.w = x1v[3] + f[i][3] * rsf * g2[i].w;
      *(float4*)(op[q] + i * 256 + lane * 4) = r4;
    }
  }
}

#define XB_TMO      128
#define XB_XCNT(j)  (256  + 64 * (j))
#define XB_XSUB(j)  (1280 + 64 * (j))
#define XB_XGEN(j)  (2304 + 64 * (j))
#define XB_TOP      3328
#define XB_TOPGEN   3392
#define XCD_BAR_WORDS 3456
#define XB_SPIN_CAP (1u << 18)
DEVINL unsigned xb_ld(unsigned* p) { return __hip_atomic_load(p, __ATOMIC_RELAXED, __HIP_MEMORY_SCOPE_AGENT); }
DEVINL unsigned xb_add(unsigned* p, unsigned v) { return __hip_atomic_fetch_add(p, v, __ATOMIC_RELAXED, __HIP_MEMORY_SCOPE_AGENT); }
DEVINL unsigned xb_xcc_id() { return (unsigned)__builtin_amdgcn_s_getreg((3 << 11) | 20) & 0xFu; }
#define XB_SPIN(cond, bar) do { unsigned _sp = 0; while (cond) { __builtin_amdgcn_s_sleep(1); \
    if ((++_sp & 255u) == 0u) { if (xb_ld(&(bar)[XB_TMO])) break; if (_sp > XB_SPIN_CAP) { atomicAdd(&(bar)[XB_TMO], 1u); break; } } } } while (0)
struct XcdBarrier { unsigned* bar; unsigned x; unsigned nloc, nx; };
DEVINL XcdBarrier xcd_barrier_post(unsigned* bar) {
  XcdBarrier b; b.bar = bar; b.x = xb_xcc_id(); b.nloc = 0u; b.nx = 0u;
  if (tidx() == 0) (void)xb_add(&bar[XB_XCNT(b.x)], 1u);
  return b;
}
DEVINL void xcd_barrier_complete(unsigned* bar, unsigned x, unsigned& nloc, unsigned& nx) {
  const unsigned G = gridDim.x;
  unsigned sum, cnt, mine, sp = 0u;
  for (;;) {
    sum = 0u; cnt = 0u; mine = 0u;
#pragma unroll
    for (unsigned j = 0; j < 16; ++j) { const unsigned c = xb_ld(&bar[XB_XCNT(j)]); sum += c; cnt += (c > 0u) ? 1u : 0u; mine = (j == x) ? c : mine; }
    if (sum == G) break;
    __builtin_amdgcn_s_sleep(1);
    if ((++sp & 255u) == 0u) { if (xb_ld(&bar[XB_TMO])) break; if (sp > XB_SPIN_CAP) { atomicAdd(&bar[XB_TMO], 1u); break; } }
  }
  nloc = mine > 0u ? mine : 1u; nx = cnt > 0u ? cnt : 1u;
}
DEVINL void xcd_barrier(XcdBarrier& b) {
  asm volatile("s_waitcnt vmcnt(0)" ::: "memory");
  __syncthreads();
  if (tidx() == 0) {
    unsigned* bar = b.bar;
    __builtin_amdgcn_s_waitcnt(0);
    if (b.nloc == 0u) xcd_barrier_complete(bar, b.x, b.nloc, b.nx);
    const unsigned nloc = b.nloc, nx = b.nx;
    const unsigned old = xb_add(&bar[XB_XSUB(b.x)], 1u);
    const unsigned gen = old / nloc;
    if (old + 1u == (gen + 1u) * nloc) {
      __builtin_amdgcn_fence(__ATOMIC_RELEASE, "agent");
      asm volatile("s_waitcnt vmcnt(0)" ::: "memory");
      const unsigned og = xb_add(&bar[XB_TOP], 1u);
      const unsigned tg = og / nx;
      if (og + 1u == (tg + 1u) * nx) xb_add(&bar[XB_TOPGEN], 1u);
      else XB_SPIN(xb_ld(&bar[XB_TOPGEN]) == tg, bar);
      __builtin_amdgcn_fence(__ATOMIC_ACQUIRE, "agent");
      xb_add(&bar[XB_XGEN(b.x)], 1u);
      asm volatile("s_waitcnt vmcnt(0)" ::: "memory");
    } else {
      XB_SPIN(xb_ld(&bar[XB_XGEN(b.x)]) == gen, bar);
      __builtin_amdgcn_fence(__ATOMIC_ACQUIRE, "agent");
      asm volatile("s_waitcnt vmcnt(0)" ::: "memory");
    }
  }
  __syncthreads();
}

constexpr int NPHASE = 11;
constexpr int S5A_BLK = 1792 / 4;
constexpr int S5CP_BLK = 2048 / 4;
constexpr int S5CS_BLK = 4096 / 4;
constexpr int GLAB_ITEMS = 544 * 4;

DEVINL int light_index(int NT, int& nlight) {
  const int bid = bidx(), nb = gridDim.x;
  const int U = MT * NT;
  nlight = nb;
  if ((nb & 7) != 0) return bid;
  const int nbx = nb >> 3, x = bid & 7, j = bid >> 3;
  int total = 0, mine = -1;
  for (int c = 0; c < 8; ++c) {
    const int n = (int)(((long)U * (c + 1)) >> 3) - (int)(((long)U * c) >> 3);
    const int r = n % nbx;
    const int nl = (r == 0) ? nbx : nbx - r;
    if (c == x) mine = (r == 0) ? total + j : ((j >= r) ? total + (j - r) : -1);
    total += nl;
  }
  nlight = total;
  return mine;
}

template <class F>
DEVINL void gemm_phase(int NT, F&& f) {
  const int bid = bidx(), nb = gridDim.x;
  const int U = MT * NT;
  if ((nb & 7) != 0) {
    for (int t = bid; t < U; t += nb) f(t / NT, t % NT);
    return;
  }
  const int x = bid & 7, j = bid >> 3, nbx = nb >> 3;
  const int u0 = (int)(((long)U * x) >> 3), u1 = (int)(((long)U * (x + 1)) >> 3);
  for (int u = u0 + j; u < u1; u += nbx) {
    const int band = u / (8 * MT), v = u - band * 8 * MT;
    const int w = min(8, NT - band * 8);
    f(v / w, band * 8 + v % w);
  }
}

DEVINL void run_phase(const Params& p, char* smem, int ph) {
  const int bid = bidx(), nb = gridDim.x;
  switch (ph) {
    case 0: phase0(p, smem); break;
    case 1:
      gemm_phase(17, [&](int mt, int nt) { p1_tile(p, smem, mt, nt); });
      {
        int nlight;
        const int li = light_index(17, nlight);
        if (li >= 0)
          for (int t = li; t < TR1 + TR2; t += nlight) mix_weight_tile(p, smem, t);
      }
      break;
    case 2:
      for (int it = bid; it < NCH + S5A_BLK; it += nb) {
        if (it < S5A_BLK) { __syncthreads(); s5_passA(p, smem, it); }
        else gla_passA(p, smem, it - S5A_BLK);
      }
      break;
    case 3:
      for (int it = bid; it < S5CP_BLK + GLAB_ITEMS + S5CS_BLK; it += nb) {
        if (it < S5CP_BLK) { __syncthreads(); s5_passC_prompt(p, smem, it); }
        else if (it < S5CP_BLK + GLAB_ITEMS) gla_passB(p, it - S5CP_BLK);
        else { __syncthreads(); s5_passC_sample(p, smem, it - S5CP_BLK - GLAB_ITEMS); }
      }
      break;
    case 4:
      gemm_phase(4, [&](int mt, int nt) { p3_tile(p, smem, mt, nt); });
      for (int it = nb - 1 - bid; it < NCH; it += nb) gla_passC(p, smem, it);
      break;
    case 5:
      break;
    case 6:
      gemm_phase(8, [&](int mt, int nt) { p4_tile(p, smem, mt, nt); });
      {
        int nlight;
        const int li = light_index(8, nlight);
        if (li >= 0)
          for (int t = li; t < TR3 + TR4; t += nlight) ffn_weight_tile(p, smem, t);
      }
      break;
    case 7:
      for (int it = bid; it < M / 16; it += nb)
        for (int i = 0; i < 4; i += 2) p5_rows<2>(p, it * 16 + (tidx() >> 6) * 4 + i);
      break;
    case 8:
      gemm_phase(44, [&](int mt, int nt) { p6_tile(p, smem, mt, nt); });
      break;
    case 9:
      gemm_phase(16, [&](int mt, int nt) { p7_tile(p, smem, mt, nt); });
      break;
    case 10:
      for (int it = bid; it < M / 8; it += nb) p8_rows<2>(p, it * 8 + (tidx() >> 6) * 2);
      break;
  }
}

#if SINGLE_LAUNCH
__global__ void __launch_bounds__(256, 2) mega_kernel(Params p) {
  __shared__ __attribute__((aligned(16))) char smem[65536];
  XcdBarrier xb = xcd_barrier_post((unsigned*)(p.ws + OFF_BAR));
  if (tidx() == 0) { __builtin_amdgcn_fence(__ATOMIC_RELEASE, ""); asm volatile("s_waitcnt vmcnt(0)" ::: "memory"); }
  xcd_barrier(xb);
#pragma unroll 1
  for (int ph = 0; ph < NPHASE; ++ph) {
    if (ph == 5) continue;
    run_phase(p, smem, ph);
    if (ph + 1 < NPHASE) xcd_barrier(xb);
  }
}
#else

__global__ void __launch_bounds__(256, 2) phase_kernel(Params p, int ph) {
  __shared__ __attribute__((aligned(16))) char smem[65536];
  run_phase(p, smem, ph);
}
#endif

extern "C" void kernel_launch(void* const* d_in, const int* in_sizes, int n_in, void* d_out, int out_size,
                              void* d_ws, size_t ws_size, hipStream_t stream) {
  Params p{};
  const float** f = (const float**)&p;
  for (int i = 0; i < 28; ++i) f[i] = (const float*)d_in[i];
  p.out = (float*)d_out;
  p.ws = (char*)d_ws;
#if SINGLE_LAUNCH
  static int grid_blocks = 0;
  if (!grid_blocks) {
    int dev = 0, cus = 0, per_cu = 0;
    hipGetDevice(&dev);
    hipDeviceGetAttribute(&cus, hipDeviceAttributeMultiprocessorCount, dev);
    hipOccupancyMaxActiveBlocksPerMultiprocessor(&per_cu, mega_kernel, 256, 0);
    if (per_cu > 2) per_cu = 2;
    grid_blocks = cus * per_cu;
  }
  hipMemsetAsync((char*)d_ws + OFF_BAR, 0, XCD_BAR_WORDS * 4, stream);
  void* args[] = {&p};
  hipError_t e = hipLaunchCooperativeKernel((void*)mega_kernel, dim3(grid_blocks), dim3(256), args, 0, stream);
  if (e != hipSuccess) fprintf(stderr, "cooperative launch failed: %s (grid %d)\n", hipGetErrorString(e), grid_blocks);
#else
  for (int ph = 0; ph < NPHASE; ++ph) phase_kernel<<<512, 256, 0, stream>>>(p, ph);
#endif
}
```
